# Optimizing an MI355X kernel written in HIP

```python
import math
import jax, jax.numpy as jnp
from jax import lax
import numpy as np

D_MODEL = 1024
BATCH = 8
SEQ = 4096
DEPTH = 2

N_BRANCH = 4
BRANCH_W = D_MODEL // 4
HEAD_DIM = 64
SB_HEADS = BRANCH_W // HEAD_DIM
SB_BLOCK = 128
SG_CHUNK = 128
SG_GROUPS = 4
SG_GD = BRANCH_W // SG_GROUPS
POOL_WINDOWS = (2, 4, 8, 16)
POOL_GD = BRANCH_W // len(POOL_WINDOWS)
CONV_W = 31
D_FF = 2816
LN_EPS = 1e-5
DN_ALPHA = (2.0 * DEPTH) ** 0.25
DN_BETA = (8.0 * DEPTH) ** -0.25

A_Q0, A_K0, A_V0 = 0, BRANCH_W, 2 * BRANCH_W
B0 = 3 * BRANCH_W
C0 = B0 + 2 * BRANCH_W
D0 = C0 + BRANCH_W
IN_COLS = D0 + 2 * BRANCH_W

kernel_name = "hybrid_gated_sb_gmlp_pool_conv_block"


def layer_norm(x, g, b):
    xf = x.astype(jnp.float32)
    mu = jnp.mean(xf, axis=-1, keepdims=True)
    var = jnp.mean(jnp.square(xf - mu), axis=-1, keepdims=True)
    y = (xf - mu) * lax.rsqrt(var + LN_EPS) * g.astype(jnp.float32) + b.astype(jnp.float32)
    return y.astype(x.dtype)


def swiglu_ffn(x, w_in, w_out):
    a, u = jnp.split(x @ w_in, 2, axis=-1)
    return (jax.nn.silu(a) * u) @ w_out


def stick_breaking_attention(q, k, v):
    S = q.shape[1]
    scale = HEAD_DIM ** -0.5
    outs = []
    for i in range(S // SB_BLOCK):
        q0 = i * SB_BLOCK
        kend = q0 + SB_BLOCK
        qb = q[:, q0:kend]
        kb = k[:, :kend]
        vb = v[:, :kend]
        z = jnp.einsum('bqhd,bkhd->bhqk', qb, kb).astype(jnp.float32) * scale
        t_pos = q0 + jnp.arange(SB_BLOCK)[:, None]
        s_pos = jnp.arange(kend)[None, :]
        causal = s_pos < t_pos
        log_keep = jnp.where(causal, jax.nn.log_sigmoid(-z), 0.0)
        after = lax.cumsum(log_keep, axis=3, reverse=True) - log_keep
        w = jnp.where(causal, jnp.exp(jax.nn.log_sigmoid(z) + after), 0.0)
        outs.append(jnp.einsum('bhqk,bkhd->bqhd', w.astype(vb.dtype), vb))
    return jnp.concatenate(outs, axis=1)


def chunked_spatial_gating(uv, ln_g, ln_b, w_s, b_s):
    B, S, _ = uv.shape
    u, v = jnp.split(uv, 2, axis=-1)
    v = layer_norm(v, ln_g, ln_b)
    vc = v.reshape(B, S // SG_CHUNK, SG_CHUNK, SG_GROUPS, SG_GD)
    mask = jnp.tril(jnp.ones((SG_CHUNK, SG_CHUNK), dtype=bool))
    ws = jnp.where(mask, w_s, jnp.zeros_like(w_s))
    mixed = jnp.einsum('gts,bcsgd->bctgd', ws, vc) + jnp.transpose(b_s)[None, None, :, :, None]
    return u * mixed.reshape(B, S, BRANCH_W)


def multiscale_pool(p, w_grp, scale):
    B, S, _ = p.shape
    pf = p.astype(jnp.float32).reshape(B, S, len(POOL_WINDOWS), POOL_GD)
    cs = jnp.cumsum(pf, axis=1)
    pos = jnp.arange(S, dtype=jnp.float32)
    outs = []
    for gi, win in enumerate(POOL_WINDOWS):
        c = cs[:, :, gi]
        prev = jnp.pad(c, ((0, 0), (win, 0), (0, 0)))[:, :S]
        cnt = jnp.minimum(pos + 1.0, float(win))[None, :, None]
        outs.append((c - prev) / cnt - pf[:, :, gi])
    pooled = jnp.stack(outs, axis=2).astype(p.dtype)
    y = jnp.einsum('bsgc,gcd->bsgd', pooled, w_grp).reshape(B, S, BRANCH_W)
    return y * scale


def conformer_conv(h, w_dw, b_dw, ln_g, ln_b):
    a, g = jnp.split(h, 2, axis=-1)
    y = a * jax.nn.sigmoid(g)
    y = lax.conv_general_dilated(
        y, w_dw[:, None, :], window_strides=(1,), padding=[(CONV_W - 1, 0)],
        dimension_numbers=('NWC', 'WIO', 'NWC'), feature_group_count=BRANCH_W) + b_dw
    y = layer_norm(y, ln_g, ln_b)
    return jax.nn.silu(y)


def hybrid_mixer(x, w_in, gate_w, gate_b, branch_w, out_w, sg_ln_g, sg_ln_b, sg_w, sg_b,
                 pool_w, pool_scale, conv_w, conv_b, conv_ln_g, conv_ln_b):
    B, S, _ = x.shape
    h = x @ w_in
    q = h[..., A_Q0:A_K0].reshape(B, S, SB_HEADS, HEAD_DIM)
    k = h[..., A_K0:A_V0].reshape(B, S, SB_HEADS, HEAD_DIM)
    v = h[..., A_V0:B0].reshape(B, S, SB_HEADS, HEAD_DIM)
    y_a = stick_breaking_attention(q, k, v).reshape(B, S, BRANCH_W)
    y_b = chunked_spatial_gating(jax.nn.gelu(h[..., B0:C0]), sg_ln_g, sg_ln_b, sg_w, sg_b)
    y_c = multiscale_pool(h[..., C0:D0], pool_w, pool_scale)
    y_d = conformer_conv(h[..., D0:IN_COLS], conv_w, conv_b, conv_ln_g, conv_ln_b)
    merged = jnp.zeros_like(x)
    for n, y in enumerate((y_a, y_b, y_c, y_d)):
        gate = jax.nn.sigmoid(x @ gate_w[n] + gate_b[n])
        merged = merged + gate * (y @ branch_w[n])
    return merged @ out_w


def setup_inputs(seed: int = 0) -> dict:
    key = jax.random.key(seed)
    ks = jax.random.split(key, 24)
    f32 = jnp.float32
    L, D, BW = DEPTH, D_MODEL, BRANCH_W
    nrm = lambda k, shape, s: jax.random.normal(k, shape, f32) * s
    return {
        "x": jax.random.normal(ks[0], (BATCH, SEQ, D), f32),
        "ln_g": 1.0 + nrm(ks[1], (L, 3, D), 0.02),
        "ln_b": nrm(ks[2], (L, 3, D), 0.02),
        "ffn_w_in": nrm(ks[3], (L, 2, D, 2 * D_FF), D ** -0.5),
        "ffn_w_out": nrm(ks[4], (L, 2, D_FF, D), DN_BETA * D_FF ** -0.5),
        "mix_w_in": nrm(ks[5], (L, D, IN_COLS), D ** -0.5),
        "gate_w": nrm(ks[6], (L, N_BRANCH, D, D), D ** -0.5),
        "gate_b": nrm(ks[7], (L, N_BRANCH, D), 0.02),
        "branch_w": nrm(ks[8], (L, N_BRANCH, BW, D), BW ** -0.5),
        "out_w": nrm(ks[9], (L, D, D), DN_BETA * D ** -0.5),
        "sg_ln_g": 1.0 + nrm(ks[10], (L, BW), 0.02),
        "sg_ln_b": nrm(ks[11], (L, BW), 0.02),
        "sg_w": nrm(ks[12], (L, SG_GROUPS, SG_CHUNK, SG_CHUNK), SG_CHUNK ** -0.5),
        "sg_b": 1.0 + nrm(ks[13], (L, SG_GROUPS, SG_CHUNK), 0.02),
        "pool_w": nrm(ks[14], (L, len(POOL_WINDOWS), POOL_GD, POOL_GD), POOL_GD ** -0.5),
        "pool_scale": 1.0 + nrm(ks[15], (L, BW), 0.02),
        "conv_w": nrm(ks[16], (L, CONV_W, BW), CONV_W ** -0.5),
        "conv_b": nrm(ks[17], (L, BW), 0.02),
        "conv_ln_g": 1.0 + nrm(ks[18], (L, BW), 0.02),
        "conv_ln_b": nrm(ks[19], (L, BW), 0.02),
    }


def reference(x, ln_g, ln_b, ffn_w_in, ffn_w_out, mix_w_in, gate_w, gate_b, branch_w, out_w,
              sg_ln_g, sg_ln_b, sg_w, sg_b, pool_w, pool_scale, conv_w, conv_b, conv_ln_g, conv_ln_b):
    for l in range(DEPTH):
        x = layer_norm(DN_ALPHA * x + 0.5 * swiglu_ffn(x, ffn_w_in[l, 0], ffn_w_out[l, 0]),
                       ln_g[l, 0], ln_b[l, 0])
        m = hybrid_mixer(x, mix_w_in[l], gate_w[l], gate_b[l], branch_w[l], out_w[l],
                         sg_ln_g[l], sg_ln_b[l], sg_w[l], sg_b[l], pool_w[l], pool_scale[l],
                         conv_w[l], conv_b[l], conv_ln_g[l], conv_ln_b[l])
        x = layer_norm(DN_ALPHA * x + m, ln_g[l, 1], ln_b[l, 1])
        x = layer_norm(DN_ALPHA * x + 0.5 * swiglu_ffn(x, ffn_w_in[l, 1], ffn_w_out[l, 1]),
                       ln_g[l, 2], ln_b[l, 2])
    return x
```

```cpp
#include <hip/hip_runtime.h>
#include <hip/hip_cooperative_groups.h>
#include <cstdio>
#include <cstdint>
namespace cg = cooperative_groups;

#define PROBE_TM 0
#define PROBE_N 2
#ifndef MK_MULTI_LAUNCH
#define MK_MULTI_LAUNCH 0
#endif

constexpr int BATCH = 8, SEQ = 4096, DM = 1024, MTOK = BATCH * SEQ, FF = 2816, BW = 256, INC = 2048, DEPTH = 2;
constexpr float LN_EPS = 1e-5f;
constexpr float DN_ALPHA = 1.41421356237f;
constexpr float LOG2E = 1.4426950408889634f;

#define LAS __attribute__((address_space(3)))
typedef unsigned short bf16_t;
typedef short bf16x8 __attribute__((ext_vector_type(8)));
typedef float f32x4 __attribute__((ext_vector_type(4)));
typedef float f32x16 __attribute__((ext_vector_type(16)));
typedef unsigned u32x4 __attribute__((ext_vector_type(4)));
typedef unsigned u32x2 __attribute__((ext_vector_type(2)));
typedef float f32x2 __attribute__((ext_vector_type(2)));

__device__ __forceinline__ unsigned cvt_pk_bf16(float lo, float hi) { unsigned r; asm volatile("v_cvt_pk_bf16_f32 %0, %1, %2" : "=v"(r) : "v"(lo), "v"(hi)); return r; }
__device__ __forceinline__ float bf_lo(unsigned w) { return __uint_as_float(w << 16); }
__device__ __forceinline__ float bf_hi(unsigned w) { return __uint_as_float(w & 0xffff0000u); }
__device__ __forceinline__ float bf2f(bf16_t h) { return __uint_as_float((unsigned)h << 16); }
__device__ __forceinline__ bf16_t f2bf(float f) { return (bf16_t)(cvt_pk_bf16(f, f) & 0xffffu); }
__device__ __forceinline__ float sigmoid_f(float x) { return __builtin_amdgcn_rcpf(1.f + __builtin_amdgcn_exp2f(-LOG2E * x)); }
__device__ __forceinline__ float silu_f(float x) { return x * sigmoid_f(x); }
__device__ __forceinline__ f32x4 sigmoid4(f32x4 x);
__device__ __forceinline__ f32x4 gelu_tanh4(f32x4 x) { return x * sigmoid4((x + (x * x) * x * 0.044715f) * 1.5957691216057308f); }
__device__ __forceinline__ f32x4 sigmoid4(f32x4 x) {
    const f32x4 t = x * (-LOG2E);
    f32x4 e; e[0] = __builtin_amdgcn_exp2f(t[0]); e[1] = __builtin_amdgcn_exp2f(t[1]); e[2] = __builtin_amdgcn_exp2f(t[2]); e[3] = __builtin_amdgcn_exp2f(t[3]);
    const f32x4 d = e + 1.0f;
    f32x4 r; r[0] = __builtin_amdgcn_rcpf(d[0]); r[1] = __builtin_amdgcn_rcpf(d[1]); r[2] = __builtin_amdgcn_rcpf(d[2]); r[3] = __builtin_amdgcn_rcpf(d[3]);
    return r;
}
__device__ __forceinline__ float gelu_tanh_f(float x) { return x * sigmoid_f(1.5957691216057308f * (x + 0.044715f * x * x * x)); }
__device__ __forceinline__ float ln_eps_s() { float e = LN_EPS; asm volatile("" : "+s"(e)); return e; }
#define swz_xor(v, pat) __int_as_float(__builtin_amdgcn_ds_swizzle(__float_as_int(v), (pat)))
__device__ __forceinline__ float partner32(float v) {
    const unsigned u = __float_as_uint(v); auto rr = __builtin_amdgcn_permlane32_swap(u, u, false, false);
    return __uint_as_float(rr[0] + rr[1] - u);
}
__device__ __forceinline__ float wave_sum(float v) {
    v += swz_xor(v, (1 << 10) | 0x1f); v += swz_xor(v, (2 << 10) | 0x1f); v += swz_xor(v, (4 << 10) | 0x1f); v += swz_xor(v, (8 << 10) | 0x1f); v += swz_xor(v, (16 << 10) | 0x1f);
    return v + partner32(v);
}

namespace pg8 {
constexpr int BM = 256, BK = 64, HALF = 128, HTB = HALF * BK * 2, STAGE_BYTES = 8 * HTB, NXCD = 8, WGM = 8;
__host__ __device__ __forceinline__ int lds_byte(int r, int c) { const int st = (r >> 4) * 2 + (c >> 5), rr = r & 15, cc = c & 31, ob = rr * 64 + cc * 2; return st * 1024 + (ob ^ (((ob >> 9) & 1) << 5)); }
__host__ __device__ __forceinline__ void stage_rc(int b, int& R, int& C) { const int st = b / 1024, sb = b % 1024, swz = sb ^ (((sb >> 9) & 1) << 5); R = (st >> 1) * 16 + swz / 64; C = (st & 1) * 32 + (swz % 64) / 2; }
__host__ __device__ __forceinline__ int perm32(int rho) { const int n = rho >> 4, i = rho & 15; return 8 * (i >> 2) + 4 * n + (i & 3); }

struct Unit { int pm, pn, ao; };
struct Gemm { const bf16_t* A; const bf16_t* Bt; int K; };

struct StaticOrder {
    int nN, G, c, ao_mode;
    __device__ __forceinline__ void init(int N, int G_, int c_, int ao_mode_) { nN = N / BM; G = G_; c = c_; ao_mode = ao_mode_; }
    __device__ __forceinline__ bool next(int i, Unit& u) const {
        constexpr int nM = MTOK / BM; const int nwg = nM * nN;
        const int L = i * G + c; if (L >= nwg) return false;
        int wgid = L; { const int q = nwg / NXCD, r = nwg % NXCD, xcd = wgid % NXCD, off = wgid / NXCD; wgid = (xcd < r ? xcd * (q + 1) : r * (q + 1) + (xcd - r) * q) + off; }
        const int nig = WGM * nN, gid = wgid / nig, fm = gid * WGM;
        u.pm = fm + ((wgid % nig) % WGM); u.pn = (wgid % nig) / WGM; u.ao = ao_mode ? (u.pn >> 2) * (MTOK * BW * 2) : 0; return true;
    }
};

typedef f32x4 Acc[2][2][4][2];

struct EpiAny {
    int kind; void* p0; void* p1; void* p2; void* p3; void* p4; float f0, f1;
    __device__ __forceinline__ bool perm() const { return kind != 4; }
    __device__ __forceinline__ void operator()(const Acc& acc, const Unit& u, int wr, int wc, int fr, int fq) const {
        asm volatile("" : "+v"(fr), "+v"(fq));
        if (kind == 0) {
            bf16_t* H = (bf16_t*)p0;
            const int row0 = u.pm * BM + wr * 64 + fr, col0 = u.pn * 128 + wc * 32 + 8 * fq;
#pragma unroll
            for (int ai = 0; ai < 2; ++ai)
#pragma unroll
                for (int m = 0; m < 4; ++m) {
                    bf16_t* rowp = H + (size_t)(row0 + ai * HALF + m * 16) * FF + col0;
                    const f32x4 g0 = acc[ai][0][m][0], g1 = acc[ai][0][m][1], u0 = acc[ai][1][m][0], u1 = acc[ai][1][m][1];
                    const f32x4 h0 = (g0 * u0) * sigmoid4(g0), h1 = (g1 * u1) * sigmoid4(g1);
                    u32x4 w;
                    w.x = cvt_pk_bf16(h0[0], h0[1]); w.y = cvt_pk_bf16(h0[2], h0[3]); w.z = cvt_pk_bf16(h1[0], h1[1]); w.w = cvt_pk_bf16(h1[2], h1[3]);
                    *(u32x4*)rowp = w;
                }
        } else if (kind == 1) {
            const bf16_t* Bp = (const bf16_t*)p0; bf16_t* Yo = (bf16_t*)p1; float* outf = (float*)p4; const float alpha = f0, s = f1;
            const float* lnp = (const float*)p2; const float* stats = (const float*)p3;
            const int row0 = u.pm * BM + wr * 64 + fr, col0 = u.pn * BM + wc * 32 + 8 * fq;
            f32x4 gg[2][2], bb[2][2];
            if (lnp) {
#pragma unroll
                for (int bj = 0; bj < 2; ++bj)
#pragma unroll
                    for (int n = 0; n < 2; ++n) { gg[bj][n] = *(const f32x4*)(lnp + col0 + bj * HALF + n * 4) * alpha; bb[bj][n] = *(const f32x4*)(lnp + DM + col0 + bj * HALF + n * 4) * alpha; }
            }
#pragma unroll
            for (int ai = 0; ai < 2; ++ai) {
#pragma unroll
              for (int mh = 0; mh < 2; ++mh) {
                u32x4 bs[4][2]; f32x2 st[4];
#pragma unroll
                for (int m = 2 * mh; m < 2 * mh + 2; ++m) {
#pragma unroll
                    for (int bj = 0; bj < 2; ++bj) bs[m][bj] = *(const u32x4*)(Bp + (size_t)(row0 + ai * HALF + m * 16) * DM + col0 + bj * HALF);
                    if (lnp) st[m] = *(const f32x2*)(stats + (size_t)(row0 + ai * HALF + m * 16) * 2);
                }
                asm volatile("" ::: "memory");
#pragma unroll
                for (int m = 2 * mh; m < 2 * mh + 2; ++m)
#pragma unroll
                    for (int bj = 0; bj < 2; ++bj) {
                        const size_t off = (size_t)(row0 + ai * HALF + m * 16) * DM + col0 + bj * HALF;
                        const u32x4 b = bs[m][bj];
                        const f32x4 b0 = {bf_lo(b.x), bf_hi(b.x), bf_lo(b.y), bf_hi(b.y)}, b1 = {bf_lo(b.z), bf_hi(b.z), bf_lo(b.w), bf_hi(b.w)};
                        f32x4 o0, o1;
                        if (lnp) { o0 = ((b0 - st[m].x) * st[m].y) * gg[bj][0] + bb[bj][0] + acc[ai][bj][m][0] * s; o1 = ((b1 - st[m].x) * st[m].y) * gg[bj][1] + bb[bj][1] + acc[ai][bj][m][1] * s; }
                        else { o0 = b0 * alpha + acc[ai][bj][m][0] * s; o1 = b1 * alpha + acc[ai][bj][m][1] * s; }
                        if (outf) { *(f32x4*)(outf + off) = o0; *(f32x4*)(outf + off + 4) = o1; }
                        else { u32x4 w; w.x = cvt_pk_bf16(o0.x, o0.y); w.y = cvt_pk_bf16(o0.z, o0.w); w.z = cvt_pk_bf16(o1.x, o1.y); w.w = cvt_pk_bf16(o1.z, o1.w); *(u32x4*)(Yo + off) = w; }
                    }
                asm volatile("" ::: "memory");
              }
            }
        } else if (kind == 2) {
            bf16_t* O = (bf16_t*)p0;
            const int row0 = u.pm * BM + wr * 64 + fr, col0 = u.pn * BM + wc * 32 + 8 * fq;
#pragma unroll
            for (int ai = 0; ai < 2; ++ai)
#pragma unroll
                for (int m = 0; m < 4; ++m) { bf16_t* rowp = O + (size_t)(row0 + ai * HALF + m * 16) * 4096 + col0;
#pragma unroll
                    for (int bj = 0; bj < 2; ++bj) { const f32x4 v0 = acc[ai][bj][m][0], v1 = acc[ai][bj][m][1]; u32x4 w; w.x = cvt_pk_bf16(v0[0], v0[1]); w.y = cvt_pk_bf16(v0[2], v0[3]); w.z = cvt_pk_bf16(v1[0], v1[1]); w.w = cvt_pk_bf16(v1[2], v1[3]);
                        *(u32x4*)(rowp + bj * HALF) = w; } }
        } else if (kind == 3) {
            bf16_t* SB = (bf16_t*)p0;
            const int row0 = u.pm * BM + wr * 64 + fr, cl0 = wc * 32 + 8 * fq;
            if (u.pn >= 6) {
                bf16_t* CGB = SB + (size_t)6 * MTOK * BW;
#pragma unroll
                for (int ai = 0; ai < 2; ++ai)
#pragma unroll
                    for (int m = 0; m < 4; ++m) {
                        bf16_t* rowp = CGB + (size_t)(row0 + ai * HALF + m * 16) * BW + (u.pn - 6) * 128 + cl0;
                        const f32x4 a0 = acc[ai][0][m][0], a1 = acc[ai][0][m][1], g0 = acc[ai][1][m][0], g1 = acc[ai][1][m][1];
                        const f32x4 y0 = a0 * sigmoid4(g0), y1 = a1 * sigmoid4(g1);
                        u32x4 w; w.x = cvt_pk_bf16(y0[0], y0[1]); w.y = cvt_pk_bf16(y0[2], y0[3]); w.z = cvt_pk_bf16(y1[0], y1[1]); w.w = cvt_pk_bf16(y1[2], y1[3]);
                        *(u32x4*)rowp = w;
                    }
            } else if (u.pn == 2 || u.pn == 4) {
                bf16_t* VT = SB + (size_t)u.pn * MTOK * BW;
                const bool act = (u.pn == 4);
#pragma unroll
                for (int ai = 0; ai < 2; ++ai)
#pragma unroll
                    for (int m = 0; m < 4; ++m) {
                        const int row = row0 + ai * HALF + m * 16, b = row >> 12, s = row & (SEQ - 1);
#pragma unroll
                        for (int bj = 0; bj < 2; ++bj) {
                            const int cl = bj * HALF + cl0;
                            f32x4 v0 = acc[ai][bj][m][0], v1 = acc[ai][bj][m][1];
                            if (act) {
                                v0 = gelu_tanh4(v0); v1 = gelu_tanh4(v1);
                                bf16_t* p = VT + ((size_t)(b * 4 + (cl >> 6)) * 64 + (cl & 63)) * SEQ + s;
                                p[0 * SEQ] = f2bf(v0[0]); p[1 * SEQ] = f2bf(v0[1]); p[2 * SEQ] = f2bf(v0[2]); p[3 * SEQ] = f2bf(v0[3]);
                                p[4 * SEQ] = f2bf(v1[0]); p[5 * SEQ] = f2bf(v1[1]); p[6 * SEQ] = f2bf(v1[2]); p[7 * SEQ] = f2bf(v1[3]);
                            } else {
                                const int ks = s & 31, rr = ks & 15, hh = (rr & 7) >> 2, ee = (rr & 3) + ((rr >> 3) << 2), d = cl & 63;
                                bf16_t* p = VT + (((((size_t)(b * 4 + (cl >> 6)) * (SEQ / 32) + (s >> 5)) * 2 + (ks >> 4)) * 2 + (d >> 5)) * 64 + (d & 31) + 32 * hh) * 8 + ee;
                                p[0 * 8] = f2bf(v0[0]); p[1 * 8] = f2bf(v0[1]); p[2 * 8] = f2bf(v0[2]); p[3 * 8] = f2bf(v0[3]);
                                p[4 * 8] = f2bf(v1[0]); p[5 * 8] = f2bf(v1[1]); p[6 * 8] = f2bf(v1[2]); p[7 * 8] = f2bf(v1[3]);
                            }
                        }
                    }
            } else if (u.pn == 1) {
                bf16_t* KF = SB + (size_t)MTOK * BW;
#pragma unroll
                for (int ai = 0; ai < 2; ++ai)
#pragma unroll
                    for (int m = 0; m < 4; ++m) {
                        const int row = row0 + ai * HALF + m * 16, b = row >> 12, s = row & (SEQ - 1);
#pragma unroll
                        for (int bj = 0; bj < 2; ++bj) {
                            const int cl = bj * HALF + cl0, d = cl & 63;
                            const f32x4 v0 = acc[ai][bj][m][0], v1 = acc[ai][bj][m][1];
                            u32x4 w; w.x = cvt_pk_bf16(v0[0], v0[1]); w.y = cvt_pk_bf16(v0[2], v0[3]); w.z = cvt_pk_bf16(v1[0], v1[1]); w.w = cvt_pk_bf16(v1[2], v1[3]);
                            *(u32x4*)(KF + ((((size_t)(b * 4 + (cl >> 6)) * (SEQ / 32) + (s >> 5)) * 4 + (d >> 4)) * 64 + (s & 31) + 32 * ((d >> 3) & 1)) * 8) = w;
                        }
                    }
            } else {
                bf16_t* O = SB + (size_t)u.pn * MTOK * BW;
                const float sc = u.pn == 0 ? 0.125f * LOG2E : 1.f;
                const bool act = (u.pn == 3);
#pragma unroll
                for (int ai = 0; ai < 2; ++ai)
#pragma unroll
                    for (int m = 0; m < 4; ++m) { bf16_t* rowp = O + (size_t)(row0 + ai * HALF + m * 16) * BW + cl0;
#pragma unroll
                        for (int bj = 0; bj < 2; ++bj) { f32x4 v0 = acc[ai][bj][m][0] * sc, v1 = acc[ai][bj][m][1] * sc;
                            if (act) {
                                v0 = gelu_tanh4(v0); v1 = gelu_tanh4(v1); }
                            u32x4 w; w.x = cvt_pk_bf16(v0[0], v0[1]); w.y = cvt_pk_bf16(v0[2], v0[3]); w.z = cvt_pk_bf16(v1[0], v1[1]); w.w = cvt_pk_bf16(v1[2], v1[3]);
                            *(u32x4*)(rowp + bj * HALF) = w; } }
            }
        } else {
            const bf16_t* P = (const bf16_t*)p0; const float* gate_b = (const float*)p1; bf16_t* MG = (bf16_t*)p2;
            const int mc = u.pn * 64 + wc * 16 + 4 * fq;
            f32x4 gb[4];
#pragma unroll
            for (int n = 0; n < 4; ++n) gb[n] = *(const f32x4*)(gate_b + n * DM + mc) * (-LOG2E);
#pragma unroll
            for (int ai = 0; ai < 2; ++ai) {
                u32x2 pw[1][4][4];
#pragma unroll
                for (int m = 0; m < 4; ++m) { const size_t row = (size_t)(u.pm * BM + ai * HALF + wr * 64 + m * 16 + fr);
#pragma unroll
                    for (int gn = 0; gn < 4; ++gn) pw[0][m][gn] = *(const u32x2*)(P + row * 4096 + gn * DM + mc); }
                asm volatile("" ::: "memory");
#pragma unroll
                for (int m = 0; m < 4; ++m) {
                    const size_t row = (size_t)(u.pm * BM + ai * HALF + wr * 64 + m * 16 + fr);
                    f32x4 sum = {0.f, 0.f, 0.f, 0.f};
#pragma unroll
                    for (int bj = 0; bj < 2; ++bj)
#pragma unroll
                        for (int n = 0; n < 2; ++n) {
                            const int gn = 2 * bj + n;
                            const u32x2 w2 = pw[0][m][gn];
                            const f32x4 pv = {bf_lo(w2.x), bf_hi(w2.x), bf_lo(w2.y), bf_hi(w2.y)};
                            const f32x4 t = acc[ai][bj][m][n] * (-LOG2E) + gb[gn];
                            f32x4 e; e[0] = __builtin_amdgcn_exp2f(t[0]); e[1] = __builtin_amdgcn_exp2f(t[1]); e[2] = __builtin_amdgcn_exp2f(t[2]); e[3] = __builtin_amdgcn_exp2f(t[3]);
                            const f32x4 d = e + 1.0f;
                            f32x4 r; r[0] = __builtin_amdgcn_rcpf(d[0]); r[1] = __builtin_amdgcn_rcpf(d[1]); r[2] = __builtin_amdgcn_rcpf(d[2]); r[3] = __builtin_amdgcn_rcpf(d[3]);
                            sum += r * pv;
                        }
                    u32x2 w; w.x = cvt_pk_bf16(sum[0], sum[1]); w.y = cvt_pk_bf16(sum[2], sum[3]);
                    *(u32x2*)(MG + row * DM + mc) = w;
                }
                asm volatile("" ::: "memory");
            }
        }
    }
};

__device__ __forceinline__ void glds_s(const char* gbase, unsigned voff, unsigned lds_dst) {
    unsigned keep;
    asm volatile("s_mov_b32 %0, m0\n\ts_mov_b32 m0, %3\n\ts_nop 2\n\tglobal_load_lds_dwordx4 %1, %2\n\ts_mov_b32 m0, %0" : "=&s"(keep) : "v"(voff), "s"(gbase), "s"(lds_dst) : "memory");
}
template <class Epi, class Sched>
__device__ __forceinline__ void gemm_phase(LAS unsigned char* lds, const Gemm g, const Sched& S, const Epi& E, const int tid) {
    const int wid = __builtin_amdgcn_readfirstlane(tid >> 6), lane = tid & 63, wr = wid >> 2, wc = wid & 3, fr = lane & 15, fq = lane >> 4;
    const int K = g.K, nt = K / BK;
    unsigned voffA, voffB;
    { int R, C; stage_rc(tid * 16, R, C); const int Rb = E.perm() ? ((R & ~31) + perm32(R & 31)) : R; voffA = (unsigned)(R * K + C) * 2u; voffB = (unsigned)(Rb * K + C) * 2u; }
    const size_t rstep = (size_t)64 * K * 2;
    const size_t kstep = (size_t)(BK * 2);
    const size_t hstep = (size_t)HALF * K * 2, tstep = 2 * hstep;
    const unsigned ldsb = (unsigned)(uintptr_t)lds + (unsigned)wid * 1024u;
    const int aoff = lds_byte(wr * 64 + fr, fq * 8), boff = lds_byte(wc * 32 + fr, fq * 8);
#define PG8_SA(b, h) (((b) * 2 + (h)) * HTB)
#define PG8_SB(b, h) ((4 + (b) * 2 + (h)) * HTB)
#define PG8_STAGE(bufoff, gbase, voff) do { glds_s((const char*)(gbase), (voff), ldsb + (bufoff)); glds_s((const char*)(gbase) + rstep, (voff), ldsb + (bufoff) + 8192u); } while (0)
#define PG8_LDA(dst, b, h) do { _Pragma("unroll") for (int m = 0; m < 4; ++m) _Pragma("unroll") for (int k = 0; k < 2; ++k) dst[m][k] = *(const LAS bf16x8*)(lds + PG8_SA(b, h) + aoff + m * 2048 + k * 1024); } while (0)
#define PG8_LDB(dst, b, h) do { _Pragma("unroll") for (int n = 0; n < 2; ++n) _Pragma("unroll") for (int k = 0; k < 2; ++k) dst[n][k] = *(const LAS bf16x8*)(lds + PG8_SB(b, h) + boff + n * 2048 + k * 1024); } while (0)
#define PG8_MMA(ai, bj, At, Bt) do { __builtin_amdgcn_s_setprio(1); _Pragma("unroll") for (int m = 0; m < 4; ++m) _Pragma("unroll") for (int n = 0; n < 2; ++n) _Pragma("unroll") for (int k = 0; k < 2; ++k) \
        acc[ai][bj][m][n] = __builtin_amdgcn_mfma_f32_16x16x32_bf16(Bt[n][k], At[m][k], acc[ai][bj][m][n], 0, 0, 0); __builtin_amdgcn_s_setprio(0); } while (0)
#define PG8_WAIT_V(n) asm volatile("s_waitcnt vmcnt(" #n ")" ::: "memory")
#define PG8_WAIT_L(n) asm volatile("s_waitcnt lgkmcnt(" #n ")" ::: "memory")
#define PG8_BAR __builtin_amdgcn_s_barrier()
#define PG8_SCHED __builtin_amdgcn_sched_barrier(0)
    Unit cur, nxt; int ui = 0;
    if (!S.next(0, cur)) return;
    Acc acc;
#pragma unroll
    for (int a = 0; a < 2; ++a)
#pragma unroll
        for (int b = 0; b < 2; ++b)
#pragma unroll
            for (int m = 0; m < 4; ++m)
#pragma unroll
                for (int n = 0; n < 2; ++n) acc[a][b][m][n] = (f32x4){0.f, 0.f, 0.f, 0.f};
    bf16x8 At[4][2], B0[2][2], B1[2][2];
    const char* cA = (const char*)g.A + (size_t)cur.pm * tstep + cur.ao; const char* cB = (const char*)g.Bt + (size_t)cur.pn * tstep;
    PG8_STAGE(PG8_SB(0, 0), cB, voffB); PG8_STAGE(PG8_SB(0, 1), cB + hstep, voffB); PG8_STAGE(PG8_SA(0, 0), cA, voffA); PG8_STAGE(PG8_SA(0, 1), cA + hstep, voffA);
    if (wr == 1) PG8_BAR;
    PG8_WAIT_V(2); PG8_BAR;
    PG8_STAGE(PG8_SB(1, 0), cB + kstep, voffB); PG8_STAGE(PG8_SA(1, 0), cA + kstep, voffA); PG8_STAGE(PG8_SB(1, 1), cB + hstep + kstep, voffB);
    PG8_WAIT_V(6); PG8_BAR;
    for (;;) {
        const bool has_next = S.next(ui + 1, nxt);
        const char* nA = has_next ? (const char*)g.A + (size_t)nxt.pm * tstep + nxt.ao : cA; const char* nB = has_next ? (const char*)g.Bt + (size_t)nxt.pn * tstep : cB;
        for (int t = 0; t < nt; t += 2) {
            const bool last = (t == nt - 2);
            const char* a1 = cA + (size_t)(t + 1) * kstep;
            const char* a2 = last ? nA : cA + (size_t)(t + 2) * kstep; const char* b2 = last ? nB : cB + (size_t)(t + 2) * kstep;
            const char* a3 = a2 + kstep; const char* b3 = b2 + kstep;
            const bool relax = (t == 0) && (ui > 0);
            PG8_LDB(B0, 0, 0); PG8_LDB(B1, 0, 1); PG8_SCHED; PG8_LDA(At, 0, 0); if (!relax) PG8_STAGE(PG8_SA(1, 1), a1 + hstep, voffA);
            if (relax) PG8_WAIT_V(16); else PG8_WAIT_V(8);
            PG8_WAIT_L(0); PG8_BAR; PG8_MMA(0, 0, At, B0); PG8_MMA(0, 1, At, B1); PG8_BAR; PG8_SCHED;
            PG8_LDA(At, 0, 1); PG8_STAGE(PG8_SB(0, 0), b2, voffB); PG8_STAGE(PG8_SB(0, 1), b2 + hstep, voffB); PG8_STAGE(PG8_SA(0, 0), a2, voffA);
            if (relax) PG8_WAIT_V(16); else PG8_WAIT_V(8);
            PG8_WAIT_L(0); PG8_BAR; PG8_MMA(1, 0, At, B0); PG8_MMA(1, 1, At, B1); PG8_BAR; PG8_SCHED;
            PG8_LDB(B0, 1, 0); PG8_LDB(B1, 1, 1); PG8_SCHED; PG8_LDA(At, 1, 0); PG8_STAGE(PG8_SA(0, 1), a2 + hstep, voffA);
            if (relax) PG8_WAIT_V(16); else PG8_WAIT_V(8);
            PG8_WAIT_L(0); PG8_BAR; PG8_MMA(0, 0, At, B0); PG8_MMA(0, 1, At, B1); PG8_BAR; PG8_SCHED;
            PG8_LDA(At, 1, 1); PG8_STAGE(PG8_SB(1, 0), b3, voffB); PG8_STAGE(PG8_SB(1, 1), b3 + hstep, voffB); PG8_STAGE(PG8_SA(1, 0), a3, voffA);
            PG8_WAIT_V(8); PG8_WAIT_L(0); PG8_BAR; PG8_MMA(1, 0, At, B0); PG8_MMA(1, 1, At, B1); PG8_BAR; PG8_SCHED;
        }
        if (wr == 0) PG8_BAR;
        if (has_next) PG8_STAGE(PG8_SA(1, 1), nA + kstep + hstep, voffA);
        E(acc, cur, wr, wc, fr, fq);
        if (!has_next) break;
#pragma unroll
        for (int a = 0; a < 2; ++a)
#pragma unroll
            for (int b = 0; b < 2; ++b)
#pragma unroll
                for (int m = 0; m < 4; ++m)
#pragma unroll
                    for (int n = 0; n < 2; ++n) acc[a][b][m][n] = (f32x4){0.f, 0.f, 0.f, 0.f};
        cur = nxt; cA = nA; cB = nB; ++ui;
        if (wr == 1) PG8_BAR;
    }
    PG8_WAIT_V(0);
    PG8_BAR;
#undef PG8_SA
#undef PG8_SB
#undef PG8_STAGE
#undef PG8_LDA
#undef PG8_LDB
#undef PG8_MMA
#undef PG8_WAIT_V
#undef PG8_WAIT_L
#undef PG8_BAR
#undef PG8_SCHED
}
}

constexpr size_t MiB = 1u << 20;
constexpr size_t WS_W = 1 * MiB;
constexpr size_t WL_UP0 = 0, WL_UP1 = 11534336, WL_DN0 = 23068672, WL_DN1 = 28835840, WL_IN = 34603008, WL_GATE = 38797312, WL_BR = 47185920, WL_OUT = 49283072, WL_SIZE = 51380224;
constexpr size_t WS_XB = 100 * MiB;
constexpr size_t WS_H = 164 * MiB;
constexpr size_t WS_YC = 164 * MiB;
constexpr size_t WS_QB = 228 * MiB, WS_KB = 244 * MiB, WS_VT = 260 * MiB, WS_UB = 276 * MiB, WS_V2B = 292 * MiB, WS_PLB = 308 * MiB, WS_CGB = 324 * MiB;
constexpr size_t WS_P = 256 * MiB;
constexpr size_t WS_YLAST = 384 * MiB;
constexpr size_t WS_END = 512 * MiB;
static_assert(WS_W + 2 * WL_SIZE <= WS_XB && WS_H + (size_t)MTOK * FF * 2 <= 340 * MiB && WS_CGB + 16 * MiB <= 340 * MiB, "ws map");

constexpr int RING_BYTES = 131072, LDS_BYTES = 147456, MISC_OFF = RING_BYTES + 320;
constexpr size_t WS_STATS = 128 * 1024;
constexpr size_t WS_LNP = 768 * 1024;
constexpr size_t WS_POOLWT = 400 * 1024;
constexpr size_t WS_SGW = 512 * 1024;
constexpr size_t WS_CTL = 0, CTL_ZERO_BYTES = 65536; constexpr int CW_BAR = 4096;

__device__ __forceinline__ int dst_row(int mode, int n, int aux) {
    if (mode == 0) return n + aux;
    if (mode == 1) { const int isup = n >= FF ? 1 : 0, j = isup ? n - FF : n; return 256 * (j >> 7) + 128 * isup + (j & 127); }
    if (mode == 2) { if (n < 1536) return n; const int c = (n - 1536) & 255, isg = (n - 1536) >> 8; return 256 * (6 + (c >> 7)) + 128 * isg + (c & 127); }
    { const int pn = n >> 6, wc = (n >> 4) & 3, rest = n & 15; return 256 * pn + 128 * (aux >> 1) + 32 * wc + 16 * (aux & 1) + rest; }
}
__device__ __forceinline__ void transpose_item(const float* W, int K, int N, bf16_t* WT, int mode, int aux, LAS float* scr, int item, int lane) {
    const int nblk = N / 32, kb = item / nblk, nb = item % nblk, k0 = 64 * kb, n0 = 32 * nb;
#pragma unroll 8
    for (int i = 0; i < 32; ++i) { const int kk = 2 * i + (lane >> 5); scr[kk * 33 + (lane & 31)] = W[(size_t)(k0 + kk) * N + n0 + (lane & 31)]; }
    asm volatile("s_waitcnt lgkmcnt(0)" ::: "memory");
    const int c = lane & 7;
#pragma unroll
    for (int j = 0; j < 4; ++j) { const int n = (lane >> 3) + 8 * j; const LAS float* s = scr + (8 * c) * 33 + n;
        u32x4 o; o.x = cvt_pk_bf16(s[0 * 33], s[1 * 33]); o.y = cvt_pk_bf16(s[2 * 33], s[3 * 33]); o.z = cvt_pk_bf16(s[4 * 33], s[5 * 33]); o.w = cvt_pk_bf16(s[6 * 33], s[7 * 33]);
        *(u32x4*)(WT + (size_t)dst_row(mode, n0 + n, aux) * K + k0 + 8 * c) = o; }
    asm volatile("s_waitcnt lgkmcnt(0)" ::: "memory");
}

__device__ __forceinline__ void ln_pass(const float* YF, float* OUT, const bf16_t* YB, bf16_t* XB, float* stats, const float* g, const float* b, bool final, int gw, int NGW, int lane) {
    if (final) {
        f32x4 gg[4], bb[4];
#pragma unroll
        for (int j = 0; j < 4; ++j) { gg[j] = ((const f32x4*)g)[lane + 64 * j]; bb[j] = ((const f32x4*)b)[lane + 64 * j]; }
        for (int m = gw; m < MTOK; m += NGW) {
            const f32x4* xr = (const f32x4*)(YF + (size_t)m * DM) + lane; f32x4* orow = (f32x4*)(OUT + (size_t)m * DM) + lane;
            f32x4 v[4]; float s = 0.f;
#pragma unroll
            for (int j = 0; j < 4; ++j) { v[j] = xr[64 * j]; s += (v[j].x + v[j].y) + (v[j].z + v[j].w); }
            const float mean = wave_sum(s) * (1.f / DM); float s2 = 0.f;
#pragma unroll
            for (int j = 0; j < 4; ++j) { v[j] = v[j] - mean; s2 += (v[j].x * v[j].x + v[j].y * v[j].y) + (v[j].z * v[j].z + v[j].w * v[j].w); }
            const float rstd = 1.f / sqrtf(wave_sum(s2) * (1.f / DM) + ln_eps_s());
#pragma unroll
            for (int j = 0; j < 4; ++j) orow[64 * j] = v[j] * rstd * gg[j] + bb[j];
        }
    } else {
        f32x4 gg[4], bb[4];
#pragma unroll
        for (int j = 0; j < 2; ++j) { gg[2 * j] = ((const f32x4*)g)[128 * j + 2 * lane]; gg[2 * j + 1] = ((const f32x4*)g)[128 * j + 2 * lane + 1]; bb[2 * j] = ((const f32x4*)b)[128 * j + 2 * lane]; bb[2 * j + 1] = ((const f32x4*)b)[128 * j + 2 * lane + 1]; }
        for (int m = gw; m < MTOK; m += NGW) {
            const u32x4* xr = (const u32x4*)(YB + (size_t)m * DM) + lane; u32x4* orow = (u32x4*)(XB + (size_t)m * DM) + lane;
            const u32x4 r0 = xr[0], r1 = xr[64];
            f32x4 v[4] = {{bf_lo(r0.x), bf_hi(r0.x), bf_lo(r0.y), bf_hi(r0.y)}, {bf_lo(r0.z), bf_hi(r0.z), bf_lo(r0.w), bf_hi(r0.w)},
                          {bf_lo(r1.x), bf_hi(r1.x), bf_lo(r1.y), bf_hi(r1.y)}, {bf_lo(r1.z), bf_hi(r1.z), bf_lo(r1.w), bf_hi(r1.w)}};
            float s = 0.f;
#pragma unroll
            for (int j = 0; j < 4; ++j) s += (v[j].x + v[j].y) + (v[j].z + v[j].w);
            const float mean = wave_sum(s) * (1.f / DM); float s2 = 0.f;
#pragma unroll
            for (int j = 0; j < 4; ++j) { v[j] = v[j] - mean; s2 += (v[j].x * v[j].x + v[j].y * v[j].y) + (v[j].z * v[j].z + v[j].w * v[j].w); }
            const float rstd = 1.f / sqrtf(wave_sum(s2) * (1.f / DM) + ln_eps_s());
            f32x4 o[4];
#pragma unroll
            for (int j = 0; j < 4; ++j) o[j] = v[j] * rstd * gg[j] + bb[j];
            u32x4 w0, w1;
            w0.x = cvt_pk_bf16(o[0].x, o[0].y); w0.y = cvt_pk_bf16(o[0].z, o[0].w); w0.z = cvt_pk_bf16(o[1].x, o[1].y); w0.w = cvt_pk_bf16(o[1].z, o[1].w);
            w1.x = cvt_pk_bf16(o[2].x, o[2].y); w1.y = cvt_pk_bf16(o[2].z, o[2].w); w1.z = cvt_pk_bf16(o[3].x, o[3].y); w1.w = cvt_pk_bf16(o[3].z, o[3].w);
            orow[0] = w0; orow[64] = w1;
            if (lane == 0) *(f32x2*)(stats + (size_t)m * 2) = (f32x2){mean, rstd};
        }
    }
}


__device__ __forceinline__ void ld_u16_s12(unsigned (&r)[12], unsigned voff, const void* const (&p)[12]) {
    asm volatile(
        "s_nop 4\n\t"
        "global_load_ushort %0, %12, %13\n\t"
        "global_load_ushort %1, %12, %14\n\t"
        "global_load_ushort %2, %12, %15\n\t"
        "global_load_ushort %3, %12, %16\n\t"
        "global_load_ushort %4, %12, %17\n\t"
        "global_load_ushort %5, %12, %18\n\t"
        "global_load_ushort %6, %12, %19\n\t"
        "global_load_ushort %7, %12, %20\n\t"
        "global_load_ushort %8, %12, %21\n\t"
        "global_load_ushort %9, %12, %22\n\t"
        "global_load_ushort %10, %12, %23\n\t"
        "global_load_ushort %11, %12, %24\n\t"
        "s_waitcnt vmcnt(0)"
        : "=&v"(r[0]), "=&v"(r[1]), "=&v"(r[2]), "=&v"(r[3]), "=&v"(r[4]), "=&v"(r[5]), "=&v"(r[6]), "=&v"(r[7]), "=&v"(r[8]), "=&v"(r[9]), "=&v"(r[10]), "=&v"(r[11])
        : "v"(voff), "s"(p[0]), "s"(p[1]), "s"(p[2]), "s"(p[3]), "s"(p[4]), "s"(p[5]), "s"(p[6]), "s"(p[7]), "s"(p[8]), "s"(p[9]), "s"(p[10]), "s"(p[11])
        : "memory");
}
__device__ __forceinline__ void ld_u16_s8(unsigned (&r)[8], unsigned voff, const void* const (&p)[8]) {
    asm volatile(
        "s_nop 4\n\t"
        "global_load_ushort %0, %8, %9\n\t"
        "global_load_ushort %1, %8, %10\n\t"
        "global_load_ushort %2, %8, %11\n\t"
        "global_load_ushort %3, %8, %12\n\t"
        "global_load_ushort %4, %8, %13\n\t"
        "global_load_ushort %5, %8, %14\n\t"
        "global_load_ushort %6, %8, %15\n\t"
        "global_load_ushort %7, %8, %16\n\t"
        "s_waitcnt vmcnt(0)"
        : "=&v"(r[0]), "=&v"(r[1]), "=&v"(r[2]), "=&v"(r[3]), "=&v"(r[4]), "=&v"(r[5]), "=&v"(r[6]), "=&v"(r[7])
        : "v"(voff), "s"(p[0]), "s"(p[1]), "s"(p[2]), "s"(p[3]), "s"(p[4]), "s"(p[5]), "s"(p[6]), "s"(p[7])
        : "memory");
}
__device__ __forceinline__ void ld_u16_s4(unsigned (&r)[4], unsigned voff, const void* const (&p)[4]) {
    asm volatile(
        "s_nop 4\n\t"
        "global_load_ushort %0, %4, %5\n\t"
        "global_load_ushort %1, %4, %6\n\t"
        "global_load_ushort %2, %4, %7\n\t"
        "global_load_ushort %3, %4, %8\n\t"
        "s_waitcnt vmcnt(0)"
        : "=&v"(r[0]), "=&v"(r[1]), "=&v"(r[2]), "=&v"(r[3])
        : "v"(voff), "s"(p[0]), "s"(p[1]), "s"(p[2]), "s"(p[3])
        : "memory");
}
__device__ __forceinline__ void ld_b128_s8(u32x4 (&r)[8], unsigned voff, const void* const (&p)[8]) {
    asm volatile(
        "s_nop 4\n\t"
        "global_load_dwordx4 %0, %8, %9\n\t"
        "global_load_dwordx4 %1, %8, %10\n\t"
        "global_load_dwordx4 %2, %8, %11\n\t"
        "global_load_dwordx4 %3, %8, %12\n\t"
        "global_load_dwordx4 %4, %8, %13\n\t"
        "global_load_dwordx4 %5, %8, %14\n\t"
        "global_load_dwordx4 %6, %8, %15\n\t"
        "global_load_dwordx4 %7, %8, %16\n\t"
        "s_waitcnt vmcnt(0)"
        : "=&v"(r[0]), "=&v"(r[1]), "=&v"(r[2]), "=&v"(r[3]), "=&v"(r[4]), "=&v"(r[5]), "=&v"(r[6]), "=&v"(r[7])
        : "v"(voff), "s"(p[0]), "s"(p[1]), "s"(p[2]), "s"(p[3]), "s"(p[4]), "s"(p[5]), "s"(p[6]), "s"(p[7])
        : "memory");
}
__device__ __forceinline__ void ld_b128_s4(u32x4 (&r)[4], unsigned voff, const void* const (&p)[4]) {
    asm volatile(
        "s_nop 4\n\t"
        "global_load_dwordx4 %0, %4, %5\n\t"
        "global_load_dwordx4 %1, %4, %6\n\t"
        "global_load_dwordx4 %2, %4, %7\n\t"
        "global_load_dwordx4 %3, %4, %8\n\t"
        "s_waitcnt vmcnt(0)"
        : "=&v"(r[0]), "=&v"(r[1]), "=&v"(r[2]), "=&v"(r[3])
        : "v"(voff), "s"(p[0]), "s"(p[1]), "s"(p[2]), "s"(p[3])
        : "memory");
}
__device__ __forceinline__ int crow(int r, int hi) { return (r & 3) + 8 * (r >> 2) + 4 * hi; }
__device__ __forceinline__ void attn_item(int item, const bf16_t* QB, const bf16_t* KB, const bf16_t* VT, bf16_t* YC, int lane) {
    const int qb = item & 127, bh = item >> 7, b = bh >> 2, h = bh & 3;
    const int q = lane & 31, hi = lane >> 5;
    const size_t rowbase = (size_t)b * SEQ; const int t0 = qb * 32;
    bf16x8 Qf[4];
#pragma unroll
    for (int d0 = 0; d0 < 4; ++d0) Qf[d0] = *(const bf16x8*)(QB + (rowbase + t0 + q) * BW + h * 64 + d0 * 16 + hi * 8);
    f32x16 o0 = {}, o1 = {};
    float carry = 1.f;
    const u32x4* kfb = (const u32x4*)KB + (size_t)bh * (SEQ / 32) * 256 + lane;
    const u32x4* vfb = (const u32x4*)VT + (size_t)bh * (SEQ / 32) * 256 + lane;
    bf16x8 Kn[4], Km[4]; u32x2 vn[2][2][2], vm[2][2][2];
#define ATT_LOAD(KD, VD, KT) do { const u32x4* kt_ = kfb + (size_t)(KT) * 256; \
        _Pragma("unroll") for (int d0 = 0; d0 < 4; ++d0) KD[d0] = __builtin_bit_cast(bf16x8, kt_[d0 * 64]); \
        const u32x4* vt_ = vfb + (size_t)(KT) * 256; \
        _Pragma("unroll") for (int dh = 0; dh < 2; ++dh) _Pragma("unroll") for (int a = 0; a < 2; ++a) { const u32x4 t_ = vt_[(a * 2 + dh) * 64]; VD[dh][a][0] = (u32x2){t_.x, t_.y}; VD[dh][a][1] = (u32x2){t_.z, t_.w}; } } while (0)
    ATT_LOAD(Kn, vn, qb);
    ATT_LOAD(Km, vm, qb > 0 ? qb - 1 : 0);
    for (int kt = qb; kt >= 0; --kt) {
        bf16x8 Kf[4]; u32x2 vraw[2][2][2];
#pragma unroll
        for (int d0 = 0; d0 < 4; ++d0) { Kf[d0] = Kn[d0]; Kn[d0] = Km[d0]; }
#pragma unroll
        for (int dh = 0; dh < 2; ++dh)
#pragma unroll
            for (int a = 0; a < 2; ++a) { vraw[dh][a][0] = vn[dh][a][0]; vraw[dh][a][1] = vn[dh][a][1]; vn[dh][a][0] = vm[dh][a][0]; vn[dh][a][1] = vm[dh][a][1]; }
        if (kt > 1) ATT_LOAD(Km, vm, kt - 2);
        f32x16 p = {};
#pragma unroll
        for (int d0 = 0; d0 < 4; ++d0) p = __builtin_amdgcn_mfma_f32_32x32x16_bf16(Kf[d0], Qf[d0], p, 0, 0, 0);
        const bool diag = (kt == qb);
        float bt[16], kp[16];
#pragma unroll
        for (int r = 0; r < 16; ++r) {
            const float e = __builtin_amdgcn_exp2f(fminf(p[r], 60.f));
            const float rc = __builtin_amdgcn_rcpf(1.f + e);
            const bool ok = !diag || (crow(r, hi) < q);
            kp[r] = ok ? rc : 1.f; bt[r] = ok ? e * rc : 0.f;
        }
        float own[4], oth[4], sg[4];
#pragma unroll
        for (int i = 0; i < 4; ++i) { own[i] = (kp[4 * i] * kp[4 * i + 1]) * (kp[4 * i + 2] * kp[4 * i + 3]); oth[i] = partner32(own[i]); }
        float tot = 1.f;
#pragma unroll
        for (int i = 3; i >= 0; --i) { sg[i] = tot * (hi == 0 ? oth[i] : 1.f); tot *= own[i] * oth[i]; }
        float w[16];
#pragma unroll
        for (int i = 0; i < 4; ++i) {
            const float a3 = sg[i] * carry, a2 = a3 * kp[4 * i + 3], a1 = a2 * kp[4 * i + 2], a0 = a1 * kp[4 * i + 1];
            w[4 * i + 3] = bt[4 * i + 3] * a3; w[4 * i + 2] = bt[4 * i + 2] * a2; w[4 * i + 1] = bt[4 * i + 1] * a1; w[4 * i + 0] = bt[4 * i + 0] * a0;
        }
        carry *= tot;
#pragma unroll
        for (int a = 0; a < 2; ++a) {
            u32x4 pw; pw.x = cvt_pk_bf16(w[8 * a + 0], w[8 * a + 1]); pw.y = cvt_pk_bf16(w[8 * a + 2], w[8 * a + 3]); pw.z = cvt_pk_bf16(w[8 * a + 4], w[8 * a + 5]); pw.w = cvt_pk_bf16(w[8 * a + 6], w[8 * a + 7]);
            const bf16x8 Pa = __builtin_bit_cast(bf16x8, pw);
            u32x4 v0; v0.x = vraw[0][a][0].x; v0.y = vraw[0][a][0].y; v0.z = vraw[0][a][1].x; v0.w = vraw[0][a][1].y;
            u32x4 v1; v1.x = vraw[1][a][0].x; v1.y = vraw[1][a][0].y; v1.z = vraw[1][a][1].x; v1.w = vraw[1][a][1].y;
            o0 = __builtin_amdgcn_mfma_f32_32x32x16_bf16(Pa, __builtin_bit_cast(bf16x8, v0), o0, 0, 0, 0);
            o1 = __builtin_amdgcn_mfma_f32_32x32x16_bf16(Pa, __builtin_bit_cast(bf16x8, v1), o1, 0, 0, 0);
        }
        if (__all(carry < 1e-37f)) break;
    }
#undef ATT_LOAD
#pragma unroll
    for (int r = 0; r < 16; ++r) {
        bf16_t* orow = YC + (rowbase + t0 + crow(r, hi)) * BW + h * 64 + q;
        orow[0] = f2bf(o0[r]); orow[32] = f2bf(o1[r]);
    }
}

__device__ __forceinline__ void sg_item(int l, int chunk, LAS unsigned char* lds, const bf16_t* UB, const bf16_t* V2T, bf16_t* YC1, const bf16_t* Wb,
                                        const float* sg_ln_g, const float* sg_ln_b, const float* sg_b, int lane, int wave) {
    constexpr int VS = 136;
    LAS bf16_t* vT = (LAS bf16_t*)lds;
    LAS float* part = (LAS float*)(lds + 256 * VS * 2);
    const size_t r0 = (size_t)chunk * 128; const int b = (int)(r0 >> 12), pos0 = (int)(r0 & (SEQ - 1));
    {
        const int th = wave & 1, cq = wave >> 1, s = 64 * th + lane;
        const bf16_t* src = V2T + ((size_t)b * BW + 64 * cq) * SEQ + pos0;
        float v[64]; float sum = 0.f, sq = 0.f;
#pragma unroll
        for (int cb = 0; cb < 64; cb += 8) {
            unsigned raw[8]; const void* pp[8];
#pragma unroll
            for (int j = 0; j < 8; ++j) pp[j] = src + (size_t)(cb + j) * SEQ;
            ld_u16_s8(raw, (unsigned)s * 2u, pp);
#pragma unroll
            for (int j = 0; j < 8; ++j) v[cb + j] = __uint_as_float(raw[j] << 16);
        }
#pragma unroll
        for (int c = 0; c < 64; ++c) { sum += v[c]; sq += v[c] * v[c]; }
        part[(cq * 128 + s) * 2] = sum; part[(cq * 128 + s) * 2 + 1] = sq;
        const float gl = sg_ln_g[l * BW + 64 * cq + lane], bl = sg_ln_b[l * BW + 64 * cq + lane];
        __syncthreads();
        float ts = 0.f, tq = 0.f;
#pragma unroll
        for (int k = 0; k < 4; ++k) { ts += part[(k * 128 + s) * 2]; tq += part[(k * 128 + s) * 2 + 1]; }
        const float mean = ts * (1.f / BW), var = fmaxf(tq * (1.f / BW) - mean * mean, 0.f), rstd = 1.f / sqrtf(var + ln_eps_s());
#pragma unroll
        for (int c = 0; c < 64; ++c) {
            const float gc = __uint_as_float(__builtin_amdgcn_readlane(__float_as_uint(gl), c)), bc = __uint_as_float(__builtin_amdgcn_readlane(__float_as_uint(bl), c));
            vT[(64 * cq + c) * VS + s] = f2bf((v[c] - mean) * rstd * gc + bc);
        }
    }
    __syncthreads();
    {
        const int g = wave & 3, dt = wave >> 2, q = lane & 31, hi = lane >> 5, c = 64 * g + 32 * dt + q;
        const bf16_t* Wg = Wb + (size_t)g * 128 * 128;
        const unsigned avoff = (unsigned)(q * 128 + 8 * hi) * 2u;
        f32x16 acc[4] = {};
        bf16x8 Bf[8];
#pragma unroll
        for (int ks = 0; ks < 8; ++ks) Bf[ks] = *(const LAS bf16x8*)(vT + c * VS + 16 * ks + 8 * hi);
#pragma unroll
        for (int i = 0; i < 4; ++i) {
#pragma unroll
            for (int kb = 0; kb < 2 * i + 2; kb += 4) {
                u32x4 af[4]; const void* pp[4];
#pragma unroll
                for (int j = 0; j < 4; ++j) pp[j] = Wg + (size_t)(32 * i) * 128 + 16 * ((kb + j) < 2 * i + 2 ? (kb + j) : 0);
                ld_b128_s4(af, avoff, pp);
#pragma unroll
                for (int j = 0; j < 4; ++j) if (kb + j < 2 * i + 2) acc[i] = __builtin_amdgcn_mfma_f32_32x32x16_bf16(__builtin_bit_cast(bf16x8, af[j]), Bf[kb + j], acc[i], 0, 0, 0);
            }
        }
        const float sb_lo = sg_b[(l * 4 + g) * 128 + lane], sb_hi = sg_b[(l * 4 + g) * 128 + 64 + lane];
        const unsigned uvoff = (unsigned)(4 * hi * BW + c) * 2u;
#pragma unroll
        for (int i = 0; i < 4; ++i) {
            unsigned uu[16];
#pragma unroll
            for (int rb = 0; rb < 16; rb += 8) {
                unsigned raw[8]; const void* pp[8];
#pragma unroll
                for (int j = 0; j < 8; ++j) pp[j] = UB + (r0 + 32 * i + crow(rb + j, 0)) * BW;
                ld_u16_s8(raw, uvoff, pp);
#pragma unroll
                for (int j = 0; j < 8; ++j) uu[rb + j] = raw[j];
            }
#pragma unroll
            for (int r = 0; r < 16; ++r) {
                const int t = 32 * i + crow(r, hi);
                const float sbv = __int_as_float(__builtin_amdgcn_ds_bpermute((t & 63) << 2, __float_as_int(i < 2 ? sb_lo : sb_hi)));
                YC1[(r0 + t) * BW + c] = f2bf(__uint_as_float(uu[r] << 16) * (acc[i][r] + sbv));
            }
        }
    }
    __syncthreads();
}

__device__ __forceinline__ void pool_item(int l, int it, LAS unsigned char* lds, const bf16_t* PLB, bf16_t* YC, const float* pool_w, const float* pool_scale, int tid, int lane, int wave) {
    constexpr int PS = 264, WS_ = 72;
    LAS bf16_t* pl = (LAS bf16_t*)lds;
    const LAS bf16_t* wT = (const LAS bf16_t*)(lds + 65536);
    const size_t r0 = (size_t)it * 64; const int pos0 = (int)(r0 & (SEQ - 1));
    {
        const int c = tid & 255, th = wave >> 2, g = (wave & 3), ts = th * 32;
        float x[47];
#pragma unroll
        for (int ib = 0; ib < 48; ib += 12) {
            unsigned raw[12]; const void* pp[12];
#pragma unroll
            for (int j = 0; j < 12; ++j) { const int off = ts - 15 + (ib + j < 47 ? ib + j : 46); pp[j] = PLB + (r0 + (pos0 + off >= 0 ? off : -pos0)) * BW; }
            ld_u16_s12(raw, (unsigned)c * 2u, pp);
#pragma unroll
            for (int j = 0; j < 12; ++j) if (ib + j < 47) x[ib + j] = (pos0 + ts - 15 + ib + j >= 0) ? __uint_as_float(raw[j] << 16) : 0.f;
        }
#define POOL_WIN(WIN) do { _Pragma("unroll") for (int t = 0; t < 32; ++t) { float s = 0.f; _Pragma("unroll") for (int j = 0; j < WIN; ++j) s += x[15 + t - j]; \
            const int pos = pos0 + ts + t; const float cnt = (float)(pos + 1 < WIN ? pos + 1 : WIN); pl[(ts + t) * PS + c] = f2bf(s / cnt - x[15 + t]); } } while (0)
        if (g == 0) POOL_WIN(2); else if (g == 1) POOL_WIN(4); else if (g == 2) POOL_WIN(8); else POOL_WIN(16);
#undef POOL_WIN
    }
    __syncthreads();
    {
        const int g = wave & 3, tt = wave >> 2, q = lane & 31, hi = lane >> 5;
        f32x16 acc0 = {}, acc1 = {};
#pragma unroll
        for (int ks = 0; ks < 4; ++ks) {
            const bf16x8 Af = *(const LAS bf16x8*)(pl + (tt * 32 + q) * PS + g * 64 + 16 * ks + 8 * hi);
            const bf16x8 B0 = *(const LAS bf16x8*)(wT + (g * 64 + q) * WS_ + 16 * ks + 8 * hi), B1 = *(const LAS bf16x8*)(wT + (g * 64 + 32 + q) * WS_ + 16 * ks + 8 * hi);
            acc0 = __builtin_amdgcn_mfma_f32_32x32x16_bf16(Af, B0, acc0, 0, 0, 0);
            acc1 = __builtin_amdgcn_mfma_f32_32x32x16_bf16(Af, B1, acc1, 0, 0, 0);
        }
        const float sc0 = pool_scale[l * BW + g * 64 + q], sc1 = pool_scale[l * BW + g * 64 + 32 + q];
        bf16_t* orow = YC + (size_t)2 * MTOK * BW + (r0 + tt * 32 + 4 * hi) * BW + g * 64 + q;
#pragma unroll
        for (int r = 0; r < 16; ++r) {
            orow[0] = f2bf(acc0[r] * sc0); orow[32] = f2bf(acc1[r] * sc1);
            orow += ((r & 3) == 3 ? 5 : 1) * BW;
        }
    }
    __syncthreads();
}

__device__ __forceinline__ void conv_item(int l, int it, LAS unsigned char* lds, const bf16_t* CGB, bf16_t* YC, const float* conv_w, const float* conv_b,
                                          const float* conv_ln_g, const float* conv_ln_b, int tid, int lane, int wave) {
    LAS float* cv = (LAS float*)lds;
    const size_t r0 = (size_t)it * 64; const int pos0 = (int)(r0 & (SEQ - 1));
    {
        const int c = tid & 255, th = wave >> 2, ts = th * 32;
        float wd[31];
#pragma unroll
        for (int j = 0; j < 31; ++j) wd[j] = conv_w[(size_t)(l * 31 + j) * BW + c];
        const float bias = conv_b[l * BW + c];
#pragma unroll 1
        for (int pass = 0; pass < 2; ++pass) {
            const int tp = ts + pass * 16;
            float x[46];
#pragma unroll
            for (int ib = 0; ib < 48; ib += 12) {
                unsigned raw[12]; const void* pp[12];
#pragma unroll
                for (int j = 0; j < 12; ++j) { const int off = tp - 30 + (ib + j < 46 ? ib + j : 45); pp[j] = CGB + (r0 + (pos0 + off >= 0 ? off : -pos0)) * BW; }
                ld_u16_s12(raw, (unsigned)c * 2u, pp);
#pragma unroll
                for (int j = 0; j < 12; ++j) if (ib + j < 46) x[ib + j] = (pos0 + tp - 30 + ib + j >= 0) ? __uint_as_float(raw[j] << 16) : 0.f;
            }
#pragma unroll
            for (int t = 0; t < 16; ++t) {
                float acc = bias;
#pragma unroll
                for (int j = 0; j < 31; ++j) acc += wd[j] * x[t + j];
                cv[(tp + t) * BW + c] = acc;
            }
        }
    }
    __syncthreads();
    {
        const f32x4 gg = *(const f32x4*)(conv_ln_g + l * BW + lane * 4), bb = *(const f32x4*)(conv_ln_b + l * BW + lane * 4);
        for (int i = 0; i < 8; ++i) {
            const int row = wave * 8 + i;
            f32x4 v = *(const LAS f32x4*)(cv + row * BW + lane * 4);
            const float mean = wave_sum((v.x + v.y) + (v.z + v.w)) * (1.f / BW);
            v = v - mean;
            const float rstd = 1.f / sqrtf(wave_sum((v.x * v.x + v.y * v.y) + (v.z * v.z + v.w * v.w)) * (1.f / BW) + ln_eps_s());
            const f32x4 y = v * rstd * gg + bb;
            u32x2 w; w.x = cvt_pk_bf16(silu_f(y.x), silu_f(y.y)); w.y = cvt_pk_bf16(silu_f(y.z), silu_f(y.w));
            *(u32x2*)(YC + (size_t)3 * MTOK * BW + (r0 + row) * BW + lane * 4) = w;
        }
    }
    __syncthreads();
}

#define XB_TMO      128
#define XB_XCNT(j)  (256  + 64 * (j))
#define XB_XSUB(j)  (1280 + 64 * (j))
#define XB_XGEN(j)  (2304 + 64 * (j))
#define XB_TOP      3328
#define XB_TOPGEN   3392
#define XCD_BAR_WORDS 3456
#define XB_SPIN_CAP (1u << 18)
__device__ __forceinline__ unsigned xb_ld(unsigned* p)              { return __hip_atomic_load(p, __ATOMIC_RELAXED, __HIP_MEMORY_SCOPE_AGENT); }
__device__ __forceinline__ unsigned xb_add(unsigned* p, unsigned v) { return __hip_atomic_fetch_add(p, v, __ATOMIC_RELAXED, __HIP_MEMORY_SCOPE_AGENT); }
__device__ __forceinline__ unsigned xb_xcc_id() { return (unsigned)__builtin_amdgcn_s_getreg((3 << 11) | 20) & 0xFu; }
#define XB_SPIN(cond, bar) do { unsigned _sp = 0; while (cond) { __builtin_amdgcn_s_sleep(1); \
    if ((++_sp & 255u) == 0u) { if (xb_ld(&(bar)[XB_TMO])) break; if (_sp > XB_SPIN_CAP) { atomicAdd(&(bar)[XB_TMO], 1u); break; } } } } while (0)
__device__ __forceinline__ void xcd_barrier_complete(unsigned* bar, unsigned x, unsigned& nloc, unsigned& nx) {
    const unsigned G = gridDim.x * gridDim.y * gridDim.z;
    unsigned sum, cnt, mine, sp = 0u;
    for (;;) {
        sum = 0u; cnt = 0u; mine = 0u;
#pragma unroll
        for (unsigned j = 0; j < 16; ++j) { const unsigned c = xb_ld(&bar[XB_XCNT(j)]); sum += c; cnt += (c > 0u) ? 1u : 0u; mine = (j == x) ? c : mine; }
        if (sum == G) break;
        __builtin_amdgcn_s_sleep(1);
        if ((++sp & 255u) == 0u) { if (xb_ld(&bar[XB_TMO])) break; if (sp > XB_SPIN_CAP) { atomicAdd(&bar[XB_TMO], 1u); break; } }
    }
    nloc = mine > 0u ? mine : 1u; nx = cnt > 0u ? cnt : 1u;
}
__device__ __forceinline__ void xcd_barrier(unsigned* bar, volatile LAS unsigned* st) {
    asm volatile("s_waitcnt vmcnt(0)" ::: "memory");
    __syncthreads();
    if (threadIdx.x == 0) {
        const unsigned x = xb_xcc_id();
        __builtin_amdgcn_s_waitcnt(0);
        unsigned nloc = st[0], nx = st[1];
        if (nloc == 0u) { xcd_barrier_complete(bar, x, nloc, nx); st[0] = nloc; st[1] = nx; }
        const unsigned old = xb_add(&bar[XB_XSUB(x)], 1u);
        const unsigned gen = old / nloc;
        if (old + 1u == (gen + 1u) * nloc) {
            __builtin_amdgcn_fence(__ATOMIC_RELEASE, "agent");
            asm volatile("s_waitcnt vmcnt(0)" ::: "memory");
            const unsigned og = xb_add(&bar[XB_TOP], 1u);
            const unsigned tg = og / nx;
            if (og + 1u == (tg + 1u) * nx) xb_add(&bar[XB_TOPGEN], 1u);
            else XB_SPIN(xb_ld(&bar[XB_TOPGEN]) == tg, bar);
            __builtin_amdgcn_fence(__ATOMIC_ACQUIRE, "agent");
            xb_add(&bar[XB_XGEN(x)], 1u);
            asm volatile("s_waitcnt vmcnt(0)" ::: "memory");
        } else {
            XB_SPIN(xb_ld(&bar[XB_XGEN(x)]) == gen, bar);
            __builtin_amdgcn_fence(__ATOMIC_ACQUIRE, "agent");
            asm volatile("s_waitcnt vmcnt(0)" ::: "memory");
        }
    }
    __syncthreads();
}

struct Args { const float* in[20]; float* out; unsigned char* ws; int ph_lo, ph_hi; };
constexpr int N_PHASES = 1 + DEPTH * 12;

__global__ void __launch_bounds__(512, 2) __attribute__((amdgpu_waves_per_eu(2, 2))) mk_fwd(Args a_) {
    extern __shared__ __attribute__((aligned(16))) unsigned char lds_raw[];
    cg::grid_group grid = cg::this_grid();
    LAS unsigned char* lds = (LAS unsigned char*)lds_raw;
    const int hi = a_.ph_hi;
    if (threadIdx.x < 64) ((LAS unsigned*)(lds + RING_BYTES))[threadIdx.x * 4 + 0] = 0u, ((LAS unsigned*)(lds + RING_BYTES))[threadIdx.x * 4 + 1] = 0u, ((LAS unsigned*)(lds + RING_BYTES))[threadIdx.x * 4 + 2] = 0u, ((LAS unsigned*)(lds + RING_BYTES))[threadIdx.x * 4 + 3] = 0u;
    __syncthreads();
    if (threadIdx.x == 0) (void)xb_add((unsigned*)(a_.ws + WS_CTL) + CW_BAR + XB_XCNT(xb_xcc_id()), 1u);
    int dup_done = 0; (void)dup_done;
    if (a_.ph_lo == 0) {
        const Args __attribute__((address_space(4)))* ap = (const Args __attribute__((address_space(4)))*)__builtin_amdgcn_kernarg_segment_ptr(); asm volatile("" : "+s"(ap));
        const Args __attribute__((address_space(4)))& a = *ap;
        int bx = blockIdx.x, G = gridDim.x; asm volatile("" : "+s"(bx), "+s"(G));
        int tid = threadIdx.x; asm volatile("" : "+v"(tid));
        const int lane = tid & 63, wave = __builtin_amdgcn_readfirstlane(tid >> 6);
        const int vcu = (G % 8 == 0) ? (bx % 8) * (G / 8) + bx / 8 : bx;
        const int gw = vcu * 8 + wave, NGW = G * 8;
        unsigned char* ws = a.ws;
        {
            LAS float* scr = (LAS float*)(lds + wave * 16384);
            constexpr int NL = 12544;
            for (int it = gw; it < DEPTH * NL; it += NGW) {
                const int l = it / NL; int r = it % NL;
                bf16_t* wl = (bf16_t*)(ws + WS_W + (size_t)l * WL_SIZE);
                if (r < 5632) { const int f = r / 2816; transpose_item(a.in[3] + (size_t)(l * 2 + f) * DM * 2 * FF, DM, 2 * FF, wl + (f ? WL_UP1 : WL_UP0) / 2, 1, 0, scr, r % 2816, lane); continue; } r -= 5632;
                if (r < 2816) { const int f = r / 1408; transpose_item(a.in[4] + (size_t)(l * 2 + f) * FF * DM, FF, DM, wl + (f ? WL_DN1 : WL_DN0) / 2, 0, 0, scr, r % 1408, lane); continue; } r -= 2816;
                if (r < 1024) { transpose_item(a.in[5] + (size_t)l * DM * INC, DM, INC, wl + WL_IN / 2, 2, 0, scr, r, lane); continue; } r -= 1024;
                if (r < 2048) { const int n = r / 512; transpose_item(a.in[6] + (size_t)(l * 4 + n) * DM * DM, DM, DM, wl + WL_GATE / 2, 3, n, scr, r % 512, lane); continue; } r -= 2048;
                if (r < 512) { const int n = r / 128; transpose_item(a.in[8] + (size_t)(l * 4 + n) * BW * DM, BW, DM, wl + WL_BR / 2, 0, n * DM, scr, r % 128, lane); continue; } r -= 512;
                transpose_item(a.in[9] + (size_t)l * DM * DM, DM, DM, wl + WL_OUT / 2, 0, 0, scr, r, lane);
            }
            for (int i = gw * 64 + lane; i < DEPTH * 4 * 128 * 128; i += NGW * 64) { const int t = (i >> 7) & 127, s = i & 127; ((bf16_t*)(ws + WS_SGW))[i] = f2bf(s <= t ? a.in[12][i] : 0.f); }
            for (int i = gw * 64 + lane; i < DEPTH * 3 * DM; i += NGW * 64) { const int k = i / DM, c = i % DM; ((float*)(ws + WS_LNP))[(k * 2) * DM + c] = a.in[1][i]; ((float*)(ws + WS_LNP))[(k * 2 + 1) * DM + c] = a.in[2][i]; }
            for (int i = gw * 64 + lane; i < DEPTH * 4 * 64 * 64; i += NGW * 64) { const int lg = i >> 12, c = (i >> 6) & 63, d = i & 63; ((bf16_t*)(ws + WS_POOLWT))[(size_t)(lg * 64 + d) * 72 + c] = f2bf(a.in[14][i]); }
            const float* x_in = a.in[0]; bf16_t* XB = (bf16_t*)(ws + WS_XB);
            for (size_t i = (size_t)gw * 64 + lane; i < (size_t)MTOK * DM / 8; i += (size_t)NGW * 64) {
                const f32x4 v0 = ((const f32x4*)x_in)[2 * i], v1 = ((const f32x4*)x_in)[2 * i + 1];
                u32x4 w; w.x = cvt_pk_bf16(v0.x, v0.y); w.y = cvt_pk_bf16(v0.z, v0.w); w.z = cvt_pk_bf16(v1.x, v1.y); w.w = cvt_pk_bf16(v1.z, v1.w);
                ((u32x4*)XB)[i] = w;
            }
        }
        if (hi > 1) xcd_barrier((unsigned*)(ws + WS_CTL) + CW_BAR, (volatile LAS unsigned*)(lds + MISC_OFF));
        if (hi < 0) grid.sync();
    }
    for (int ph = (a_.ph_lo > 0 ? a_.ph_lo : 1); ph < hi; ++ph) {
        const Args __attribute__((address_space(4)))* ap = (const Args __attribute__((address_space(4)))*)__builtin_amdgcn_kernarg_segment_ptr(); asm volatile("" : "+s"(ap));
        const Args __attribute__((address_space(4)))& a = *ap;
        int bx = blockIdx.x, G = gridDim.x; asm volatile("" : "+s"(bx), "+s"(G));
        int tid = threadIdx.x; asm volatile("" : "+v"(tid));
        const int lane = tid & 63, wave = __builtin_amdgcn_readfirstlane(tid >> 6);
        const int vcu = (G % 8 == 0) ? (bx % 8) * (G / 8) + bx / 8 : bx;
        const int gw = vcu * 8 + wave, NGW = G * 8;
        unsigned char* ws = a.ws;
        {
            const int l = (ph - 1) / 12, s = (ph - 1) % 12;
            const unsigned char* wl = ws + WS_W + (size_t)l * WL_SIZE;
            if (s == 2 || s == 8 || s == 11) {
                const int k = s == 2 ? 0 : s == 8 ? 1 : 2;
                ln_pass((const float*)(ws + WS_YLAST), a.out, (const bf16_t*)a.out, (bf16_t*)(ws + WS_XB), (float*)(ws + WS_STATS), a.in[1] + (size_t)(l * 3 + k) * DM, a.in[2] + (size_t)(l * 3 + k) * DM, l == DEPTH - 1 && k == 2, gw, NGW, lane);
            } else if (s == 4) {
                bf16_t* YC = (bf16_t*)(ws + WS_YC);
                const bf16_t *QB = (const bf16_t*)(ws + WS_QB), *KB = (const bf16_t*)(ws + WS_KB), *VT = (const bf16_t*)(ws + WS_VT), *UB = (const bf16_t*)(ws + WS_UB), *V2B = (const bf16_t*)(ws + WS_V2B), *PLB = (const bf16_t*)(ws + WS_PLB), *CGB = (const bf16_t*)(ws + WS_CGB);
#ifndef SKIP_SG
                for (int rr = 0; rr < (PROBE_TM == 1 ? 3 : 1); ++rr)
                for (int it = vcu; it < MTOK / 128; it += G) sg_item(l, it, lds, UB, V2B, YC + (size_t)MTOK * BW, (const bf16_t*)(ws + WS_SGW) + (size_t)l * 4 * 128 * 128, a.in[10], a.in[11], a.in[13], lane, wave);
#endif
                {
                    const u32x4* srcw = (const u32x4*)(ws + WS_POOLWT + (size_t)l * 4 * 64 * 72 * 2);
                    for (int i = tid; i < 4 * 64 * 72 * 2 / 16; i += 512) ((LAS u32x4*)(lds + 65536))[i] = srcw[i];
                    __syncthreads();
                }
#ifndef SKIP_POOL
                for (int rr = 0; rr < (PROBE_TM == 2 ? 3 : 1); ++rr)
                for (int it = vcu; it < MTOK / 64; it += G) pool_item(l, it, lds, PLB, YC, a.in[14], a.in[15], tid, lane, wave);
#endif
#ifndef SKIP_CONV
                for (int rr = 0; rr < (PROBE_TM == 3 ? 3 : 1); ++rr)
                for (int it = vcu; it < MTOK / 64; it += G) conv_item(l, it, lds, CGB, YC, a.in[16], a.in[17], a.in[18], a.in[19], tid, lane, wave);
#endif
#ifndef SKIP_ATTN
                for (int rr = 0; rr < (PROBE_TM == 4 ? 3 : 1); ++rr)
                for (int it = gw; it < BATCH * 4 * (SEQ / 32); it += NGW) attn_item(it, QB, KB, VT, YC, lane);
#endif
            } else {
                pg8::Gemm g; pg8::EpiAny E; pg8::StaticOrder S;
                E.p1 = nullptr; E.p2 = nullptr; E.p3 = ws + WS_STATS; E.p4 = nullptr; E.f0 = 0.f; E.f1 = 0.f;
                if (s == 0 || s == 9) {
                    g = pg8::Gemm{(const bf16_t*)(ws + WS_XB), (const bf16_t*)(wl + (s ? WL_UP1 : WL_UP0)), DM}; S.init(2 * FF, G, bx, 0);
                    E.kind = 0; E.p0 = ws + WS_H;
                } else if (s == 1 || s == 10) {
                    g = pg8::Gemm{(const bf16_t*)(ws + WS_H), (const bf16_t*)(wl + (s == 10 ? WL_DN1 : WL_DN0)), FF}; S.init(DM, G, bx, 0);
                    E.kind = 1; E.p0 = (ph == 2) ? (void*)(ws + WS_XB) : (void*)a.out; E.p1 = a.out; E.f0 = DN_ALPHA; E.f1 = 0.5f;
                    if (ph != 2) E.p2 = ws + WS_LNP + (size_t)((l * 3 + (s == 1 ? 0 : 2)) - 1) * 2 * DM * 4;
                    if (l == DEPTH - 1 && s == 10) E.p4 = ws + WS_YLAST;
                } else if (s == 3) {
                    g = pg8::Gemm{(const bf16_t*)(ws + WS_XB), (const bf16_t*)(wl + WL_IN), DM}; S.init(INC, G, bx, 0);
                    E.kind = 3; E.p0 = ws + WS_QB;
                } else if (s == 5) {
                    g = pg8::Gemm{(const bf16_t*)(ws + WS_YC), (const bf16_t*)(wl + WL_BR), BW}; S.init(4 * DM, G, bx, 1);
                    E.kind = 2; E.p0 = ws + WS_P;
                } else if (s == 6) {
                    g = pg8::Gemm{(const bf16_t*)(ws + WS_XB), (const bf16_t*)(wl + WL_GATE), DM}; S.init(4 * DM, G, bx, 0);
                    E.kind = 4; E.p0 = ws + WS_P; E.p1 = (void*)(a.in[7] + (size_t)l * 4 * DM); E.p2 = ws + WS_YC;
                } else {
                    g = pg8::Gemm{(const bf16_t*)(ws + WS_YC), (const bf16_t*)(wl + WL_OUT), DM}; S.init(DM, G, bx, 0);
                    E.kind = 1; E.p0 = a.out; E.p1 = a.out; E.f0 = DN_ALPHA; E.f1 = 1.0f; E.p2 = ws + WS_LNP + (size_t)(l * 3) * 2 * DM * 4;
                }
#ifndef SKIP_GEMM
                pg8::gemm_phase(lds, g, S, E, tid);
#endif
            }
        }
        if (ph + 1 < hi) {
            xcd_barrier((unsigned*)(ws + WS_CTL) + CW_BAR, (volatile LAS unsigned*)(lds + MISC_OFF));
        }
#ifdef PROBE_DUP
        if (ph > 0 && (ph - 1) % 12 == PROBE_DUP && dup_done < PROBE_N - 1) { ++dup_done; --ph; } else dup_done = 0;
#endif
    }
}

extern "C" void kernel_launch(void* const* d_in, const int* in_sizes, int n_in, void* d_out, int out_size, void* d_ws, size_t ws_size, hipStream_t stream) {
    static int grid = 0;
    if (grid == 0) {
        if (n_in != 20 || in_sizes[0] != MTOK * DM || out_size != MTOK * DM || ws_size < WS_END) { fprintf(stderr, "kernel_launch: unexpected shapes / workspace (n_in %d, ws %zu); nothing launched\n", n_in, ws_size); grid = -1; return; }
        int dev = 0, cus = 0, per_cu = 0;
        if (hipGetDevice(&dev) != hipSuccess || hipDeviceGetAttribute(&cus, hipDeviceAttributeMultiprocessorCount, dev) != hipSuccess) { grid = -1; return; }
        if (hipFuncSetAttribute((const void*)mk_fwd, hipFuncAttributeMaxDynamicSharedMemorySize, LDS_BYTES) != hipSuccess) { fprintf(stderr, "kernel_launch: hipFuncSetAttribute failed\n"); grid = -1; return; }
        if (hipOccupancyMaxActiveBlocksPerMultiprocessor(&per_cu, (const void*)mk_fwd, 512, LDS_BYTES) != hipSuccess || per_cu < 1) { fprintf(stderr, "kernel_launch: occupancy query says %d\n", per_cu); per_cu = 1; }
        (void)hipGetLastError();
        grid = cus;
    }
    if (grid < 0) return;
    if (hipMemsetAsync((char*)d_ws + WS_CTL, 0, CTL_ZERO_BYTES, stream) != hipSuccess) { fprintf(stderr, "kernel_launch: hipMemsetAsync failed\n"); return; }
    Args a{};
    for (int i = 0; i < 20; ++i) a.in[i] = (const float*)d_in[i];
    a.out = (float*)d_out; a.ws = (unsigned char*)d_ws;
#if MK_MULTI_LAUNCH
    for (int p = 0; p < N_PHASES; ++p) {
        a.ph_lo = p; a.ph_hi = p + 1;
        void* args[] = {&a};
        hipError_t e = hipLaunchCooperativeKernel((const void*)mk_fwd, dim3(grid), dim3(512), args, LDS_BYTES, stream);
        if (e != hipSuccess) { fprintf(stderr, "kernel_launch: launch %d failed: %s\n", p, hipGetErrorString(e)); break; }
    }
#else
    a.ph_lo = 0; a.ph_hi = N_PHASES;
    void* args[] = {&a};
    hipError_t e = hipLaunchCooperativeKernel((const void*)mk_fwd, dim3(grid), dim3(512), args, LDS_BYTES, stream);
    if (e != hipSuccess) fprintf(stderr, "kernel_launch: cooperative launch failed: %s (grid %d)\n", hipGetErrorString(e), grid);
#endif
}
```

```cpp
#include <hip/hip_runtime.h>
#include <hip/hip_cooperative_groups.h>
#include <cstdio>
#include <cstdint>
namespace cg = cooperative_groups;

#define PROBE_TM 0
#define PROBE_N 2
#ifndef MK_MULTI_LAUNCH
#define MK_MULTI_LAUNCH 0
#endif

constexpr int BATCH = 8, SEQ = 4096, DM = 1024, MTOK = BATCH * SEQ, FF = 2816, BW = 256, INC = 2048, DEPTH = 2;
constexpr float LN_EPS = 1e-5f;
constexpr float DN_ALPHA = 1.41421356237f;
constexpr float LOG2E = 1.4426950408889634f;

#define LAS __attribute__((address_space(3)))
typedef unsigned short bf16_t;
typedef short bf16x8 __attribute__((ext_vector_type(8)));
typedef float f32x4 __attribute__((ext_vector_type(4)));
typedef float f32x16 __attribute__((ext_vector_type(16)));
typedef unsigned u32x4 __attribute__((ext_vector_type(4)));
typedef unsigned u32x2 __attribute__((ext_vector_type(2)));
typedef float f32x2 __attribute__((ext_vector_type(2)));

__device__ __forceinline__ unsigned cvt_pk_bf16(float lo, float hi) { unsigned r; asm volatile("v_cvt_pk_bf16_f32 %0, %1, %2" : "=v"(r) : "v"(lo), "v"(hi)); return r; }
__device__ __forceinline__ float bf_lo(unsigned w) { return __uint_as_float(w << 16); }
__device__ __forceinline__ float bf_hi(unsigned w) { return __uint_as_float(w & 0xffff0000u); }
__device__ __forceinline__ float bf2f(bf16_t h) { return __uint_as_float((unsigned)h << 16); }
__device__ __forceinline__ bf16_t f2bf(float f) { return (bf16_t)(cvt_pk_bf16(f, f) & 0xffffu); }
__device__ __forceinline__ float sigmoid_f(float x) { return __builtin_amdgcn_rcpf(1.f + __builtin_amdgcn_exp2f(-LOG2E * x)); }
__device__ __forceinline__ float silu_f(float x) { return x * sigmoid_f(x); }
__device__ __forceinline__ f32x4 sigmoid4(f32x4 x);
__device__ __forceinline__ f32x4 gelu_tanh4(f32x4 x) { return x * sigmoid4((x + (x * x) * x * 0.044715f) * 1.5957691216057308f); }
__device__ __forceinline__ f32x4 sigmoid4(f32x4 x) {
    const f32x4 t = x * (-LOG2E);
    f32x4 e; e[0] = __builtin_amdgcn_exp2f(t[0]); e[1] = __builtin_amdgcn_exp2f(t[1]); e[2] = __builtin_amdgcn_exp2f(t[2]); e[3] = __builtin_amdgcn_exp2f(t[3]);
    const f32x4 d = e + 1.0f;
    f32x4 r; r[0] = __builtin_amdgcn_rcpf(d[0]); r[1] = __builtin_amdgcn_rcpf(d[1]); r[2] = __builtin_amdgcn_rcpf(d[2]); r[3] = __builtin_amdgcn_rcpf(d[3]);
    return r;
}
__device__ __forceinline__ float gelu_tanh_f(float x) { return x * sigmoid_f(1.5957691216057308f * (x + 0.044715f * x * x * x)); }
__device__ __forceinline__ float ln_eps_s() { float e = LN_EPS; asm volatile("" : "+s"(e)); return e; }
#define swz_xor(v, pat) __int_as_float(__builtin_amdgcn_ds_swizzle(__float_as_int(v), (pat)))
__device__ __forceinline__ float partner32(float v) {
    const unsigned u = __float_as_uint(v); auto rr = __builtin_amdgcn_permlane32_swap(u, u, false, false);
    return __uint_as_float(rr[0] + rr[1] - u);
}
__device__ __forceinline__ float wave_sum(float v) {
    v += swz_xor(v, (1 << 10) | 0x1f); v += swz_xor(v, (2 << 10) | 0x1f); v += swz_xor(v, (4 << 10) | 0x1f); v += swz_xor(v, (8 << 10) | 0x1f); v += swz_xor(v, (16 << 10) | 0x1f);
    return v + partner32(v);
}

namespace pg8 {
constexpr int BM = 256, BK = 64, HALF = 128, HTB = HALF * BK * 2, STAGE_BYTES = 8 * HTB, NXCD = 8, WGM = 8;
__host__ __device__ __forceinline__ int lds_byte(int r, int c) { const int st = (r >> 4) * 2 + (c >> 5), rr = r & 15, cc = c & 31, ob = rr * 64 + cc * 2; return st * 1024 + (ob ^ (((ob >> 9) & 1) << 5)); }
__host__ __device__ __forceinline__ void stage_rc(int b, int& R, int& C) { const int st = b / 1024, sb = b % 1024, swz = sb ^ (((sb >> 9) & 1) << 5); R = (st >> 1) * 16 + swz / 64; C = (st & 1) * 32 + (swz % 64) / 2; }
__host__ __device__ __forceinline__ int perm32(int rho) { const int n = rho >> 4, i = rho & 15; return 8 * (i >> 2) + 4 * n + (i & 3); }

struct Unit { int pm, pn, ao; };
struct Gemm { const bf16_t* A; const bf16_t* Bt; int K; };

struct StaticOrder {
    int nN, G, c, ao_mode;
    __device__ __forceinline__ void init(int N, int G_, int c_, int ao_mode_) { nN = N / BM; G = G_; c = c_; ao_mode = ao_mode_; }
    __device__ __forceinline__ bool next(int i, Unit& u) const {
        constexpr int nM = MTOK / BM; const int nwg = nM * nN;
        const int L = i * G + c; if (L >= nwg) return false;
        int wgid = L; { const int q = nwg / NXCD, r = nwg % NXCD, xcd = wgid % NXCD, off = wgid / NXCD; wgid = (xcd < r ? xcd * (q + 1) : r * (q + 1) + (xcd - r) * q) + off; }
        const int nig = WGM * nN, gid = wgid / nig, fm = gid * WGM;
        u.pm = fm + ((wgid % nig) % WGM); u.pn = (wgid % nig) / WGM; u.ao = ao_mode ? (u.pn >> 2) * (MTOK * BW * 2) : 0; return true;
    }
};

typedef f32x4 Acc[2][2][4][2];

struct EpiAny {
    int kind; void* p0; void* p1; void* p2; void* p3; void* p4; float f0, f1;
    __device__ __forceinline__ bool perm() const { return kind != 4; }
    __device__ __forceinline__ void operator()(const Acc& acc, const Unit& u, int wr, int wc, int fr, int fq) const {
        asm volatile("" : "+v"(fr), "+v"(fq));
        if (kind == 0) {
            bf16_t* H = (bf16_t*)p0;
            const int row0 = u.pm * BM + wr * 64 + fr, col0 = u.pn * 128 + wc * 32 + 8 * fq;
#pragma unroll
            for (int ai = 0; ai < 2; ++ai)
#pragma unroll
                for (int m = 0; m < 4; ++m) {
                    bf16_t* rowp = H + (size_t)(row0 + ai * HALF + m * 16) * FF + col0;
                    const f32x4 g0 = acc[ai][0][m][0], g1 = acc[ai][0][m][1], u0 = acc[ai][1][m][0], u1 = acc[ai][1][m][1];
                    const f32x4 h0 = (g0 * u0) * sigmoid4(g0), h1 = (g1 * u1) * sigmoid4(g1);
                    u32x4 w;
                    w.x = cvt_pk_bf16(h0[0], h0[1]); w.y = cvt_pk_bf16(h0[2], h0[3]); w.z = cvt_pk_bf16(h1[0], h1[1]); w.w = cvt_pk_bf16(h1[2], h1[3]);
                    *(u32x4*)rowp = w;
                }
        } else if (kind == 1) {
            const bf16_t* Bp = (const bf16_t*)p0; bf16_t* Yo = (bf16_t*)p1; float* outf = (float*)p4; const float alpha = f0, s = f1;
            const float* lnp = (const float*)p2; const float* stats = (const float*)p3;
            const int row0 = u.pm * BM + wr * 64 + fr, col0 = u.pn * BM + wc * 32 + 8 * fq;
            f32x4 gg[2][2], bb[2][2];
            if (lnp) {
#pragma unroll
                for (int bj = 0; bj < 2; ++bj)
#pragma unroll
                    for (int n = 0; n < 2; ++n) { gg[bj][n] = *(const f32x4*)(lnp + col0 + bj * HALF + n * 4) * alpha; bb[bj][n] = *(const f32x4*)(lnp + DM + col0 + bj * HALF + n * 4) * alpha; }
            }
#pragma unroll
            for (int ai = 0; ai < 2; ++ai) {
#pragma unroll
              for (int mh = 0; mh < 2; ++mh) {
                u32x4 bs[4][2]; f32x2 st[4];
#pragma unroll
                for (int m = 2 * mh; m < 2 * mh + 2; ++m) {
#pragma unroll
                    for (int bj = 0; bj < 2; ++bj) bs[m][bj] = *(const u32x4*)(Bp + (size_t)(row0 + ai * HALF + m * 16) * DM + col0 + bj * HALF);
                    if (lnp) st[m] = *(const f32x2*)(stats + (size_t)(row0 + ai * HALF + m * 16) * 2);
                }
                asm volatile("" ::: "memory");
#pragma unroll
                for (int m = 2 * mh; m < 2 * mh + 2; ++m)
#pragma unroll
                    for (int bj = 0; bj < 2; ++bj) {
                        const size_t off = (size_t)(row0 + ai * HALF + m * 16) * DM + col0 + bj * HALF;
                        const u32x4 b = bs[m][bj];
                        const f32x4 b0 = {bf_lo(b.x), bf_hi(b.x), bf_lo(b.y), bf_hi(b.y)}, b1 = {bf_lo(b.z), bf_hi(b.z), bf_lo(b.w), bf_hi(b.w)};
                        f32x4 o0, o1;
                        if (lnp) { o0 = ((b0 - st[m].x) * st[m].y) * gg[bj][0] + bb[bj][0] + acc[ai][bj][m][0] * s; o1 = ((b1 - st[m].x) * st[m].y) * gg[bj][1] + bb[bj][1] + acc[ai][bj][m][1] * s; }
                        else { o0 = b0 * alpha + acc[ai][bj][m][0] * s; o1 = b1 * alpha + acc[ai][bj][m][1] * s; }
                        if (outf) { *(f32x4*)(outf + off) = o0; *(f32x4*)(outf + off + 4) = o1; }
                        else { u32x4 w; w.x = cvt_pk_bf16(o0.x, o0.y); w.y = cvt_pk_bf16(o0.z, o0.w); w.z = cvt_pk_bf16(o1.x, o1.y); w.w = cvt_pk_bf16(o1.z, o1.w); *(u32x4*)(Yo + off) = w; }
                    }
                asm volatile("" ::: "memory");
              }
            }
        } else if (kind == 2) {
            bf16_t* O = (bf16_t*)p0;
            const int row0 = u.pm * BM + wr * 64 + fr, col0 = u.pn * BM + wc * 32 + 8 * fq;
#pragma unroll
            for (int ai = 0; ai < 2; ++ai)
#pragma unroll
                for (int m = 0; m < 4; ++m) { bf16_t* rowp = O + (size_t)(row0 + ai * HALF + m * 16) * 4096 + col0;
#pragma unroll
                    for (int bj = 0; bj < 2; ++bj) { const f32x4 v0 = acc[ai][bj][m][0], v1 = acc[ai][bj][m][1]; u32x4 w; w.x = cvt_pk_bf16(v0[0], v0[1]); w.y = cvt_pk_bf16(v0[2], v0[3]); w.z = cvt_pk_bf16(v1[0], v1[1]); w.w = cvt_pk_bf16(v1[2], v1[3]);
                        *(u32x4*)(rowp + bj * HALF) = w; } }
        } else if (kind == 3) {
            bf16_t* SB = (bf16_t*)p0;
            const int row0 = u.pm * BM + wr * 64 + fr, cl0 = wc * 32 + 8 * fq;
            if (u.pn >= 6) {
                bf16_t* CGB = SB + (size_t)6 * MTOK * BW;
#pragma unroll
                for (int ai = 0; ai < 2; ++ai)
#pragma unroll
                    for (int m = 0; m < 4; ++m) {
                        bf16_t* rowp = CGB + (size_t)(row0 + ai * HALF + m * 16) * BW + (u.pn - 6) * 128 + cl0;
                        const f32x4 a0 = acc[ai][0][m][0], a1 = acc[ai][0][m][1], g0 = acc[ai][1][m][0], g1 = acc[ai][1][m][1];
                        const f32x4 y0 = a0 * sigmoid4(g0), y1 = a1 * sigmoid4(g1);
                        u32x4 w; w.x = cvt_pk_bf16(y0[0], y0[1]); w.y = cvt_pk_bf16(y0[2], y0[3]); w.z = cvt_pk_bf16(y1[0], y1[1]); w.w = cvt_pk_bf16(y1[2], y1[3]);
                        *(u32x4*)rowp = w;
                    }
            } else if (u.pn == 2 || u.pn == 4) {
                bf16_t* VT = SB + (size_t)u.pn * MTOK * BW;
                const bool act = (u.pn == 4);
#pragma unroll
                for (int ai = 0; ai < 2; ++ai)
#pragma unroll
                    for (int m = 0; m < 4; ++m) {
                        const int row = row0 + ai * HALF + m * 16, b = row >> 12, s = row & (SEQ - 1);
#pragma unroll
                        for (int bj = 0; bj < 2; ++bj) {
                            const int cl = bj * HALF + cl0;
                            f32x4 v0 = acc[ai][bj][m][0], v1 = acc[ai][bj][m][1];
                            if (act) {
                                v0 = gelu_tanh4(v0); v1 = gelu_tanh4(v1);
                                bf16_t* p = VT + ((size_t)(b * 4 + (cl >> 6)) * 64 + (cl & 63)) * SEQ + s;
                                p[0 * SEQ] = f2bf(v0[0]); p[1 * SEQ] = f2bf(v0[1]); p[2 * SEQ] = f2bf(v0[2]); p[3 * SEQ] = f2bf(v0[3]);
                                p[4 * SEQ] = f2bf(v1[0]); p[5 * SEQ] = f2bf(v1[1]); p[6 * SEQ] = f2bf(v1[2]); p[7 * SEQ] = f2bf(v1[3]);
                            } else {
                                const int ks = s & 31, rr = ks & 15, hh = (rr & 7) >> 2, ee = (rr & 3) + ((rr >> 3) << 2), d = cl & 63;
                                bf16_t* p = VT + (((((size_t)(b * 4 + (cl >> 6)) * (SEQ / 32) + (s >> 5)) * 2 + (ks >> 4)) * 2 + (d >> 5)) * 64 + (d & 31) + 32 * hh) * 8 + ee;
                                p[0 * 8] = f2bf(v0[0]); p[1 * 8] = f2bf(v0[1]); p[2 * 8] = f2bf(v0[2]); p[3 * 8] = f2bf(v0[3]);
                                p[4 * 8] = f2bf(v1[0]); p[5 * 8] = f2bf(v1[1]); p[6 * 8] = f2bf(v1[2]); p[7 * 8] = f2bf(v1[3]);
                            }
                        }
                    }
            } else if (u.pn == 1) {
                bf16_t* KF = SB + (size_t)MTOK * BW;
#pragma unroll
                for (int ai = 0; ai < 2; ++ai)
#pragma unroll
                    for (int m = 0; m < 4; ++m) {
                        const int row = row0 + ai * HALF + m * 16, b = row >> 12, s = row & (SEQ - 1);
#pragma unroll
                        for (int bj = 0; bj < 2; ++bj) {
                            const int cl = bj * HALF + cl0, d = cl & 63;
                            const f32x4 v0 = acc[ai][bj][m][0], v1 = acc[ai][bj][m][1];
                            u32x4 w; w.x = cvt_pk_bf16(v0[0], v0[1]); w.y = cvt_pk_bf16(v0[2], v0[3]); w.z = cvt_pk_bf16(v1[0], v1[1]); w.w = cvt_pk_bf16(v1[2], v1[3]);
                            *(u32x4*)(KF + ((((size_t)(b * 4 + (cl >> 6)) * (SEQ / 32) + (s >> 5)) * 4 + (d >> 4)) * 64 + (s & 31) + 32 * ((d >> 3) & 1)) * 8) = w;
                        }
                    }
            } else {
                bf16_t* O = SB + (size_t)u.pn * MTOK * BW;
                const float sc = u.pn == 0 ? 0.125f * LOG2E : 1.f;
                const bool act = (u.pn == 3);
#pragma unroll
                for (int ai = 0; ai < 2; ++ai)
#pragma unroll
                    for (int m = 0; m < 4; ++m) { bf16_t* rowp = O + (size_t)(row0 + ai * HALF + m * 16) * BW + cl0;
#pragma unroll
                        for (int bj = 0; bj < 2; ++bj) { f32x4 v0 = acc[ai][bj][m][0] * sc, v1 = acc[ai][bj][m][1] * sc;
                            if (act) {
                                v0 = gelu_tanh4(v0); v1 = gelu_tanh4(v1); }
                            u32x4 w; w.x = cvt_pk_bf16(v0[0], v0[1]); w.y = cvt_pk_bf16(v0[2], v0[3]); w.z = cvt_pk_bf16(v1[0], v1[1]); w.w = cvt_pk_bf16(v1[2], v1[3]);
                            *(u32x4*)(rowp + bj * HALF) = w; } }
            }
        } else {
            const bf16_t* P = (const bf16_t*)p0; const float* gate_b = (const float*)p1; bf16_t* MG = (bf16_t*)p2;
            const int mc = u.pn * 64 + wc * 16 + 4 * fq;
            f32x4 gb[4];
#pragma unroll
            for (int n = 0; n < 4; ++n) gb[n] = *(const f32x4*)(gate_b + n * DM + mc);
#pragma unroll
            for (int ai = 0; ai < 2; ++ai) {
                u32x2 pw[1][4][4];
#pragma unroll
                for (int m = 0; m < 4; ++m) { const size_t row = (size_t)(u.pm * BM + ai * HALF + wr * 64 + m * 16 + fr);
#pragma unroll
                    for (int gn = 0; gn < 4; ++gn) pw[0][m][gn] = *(const u32x2*)(P + row * 4096 + gn * DM + mc); }
                asm volatile("" ::: "memory");
#pragma unroll
                for (int m = 0; m < 4; ++m) {
                    const size_t row = (size_t)(u.pm * BM + ai * HALF + wr * 64 + m * 16 + fr);
                    f32x4 sum = {0.f, 0.f, 0.f, 0.f};
#pragma unroll
                    for (int bj = 0; bj < 2; ++bj)
#pragma unroll
                        for (int n = 0; n < 2; ++n) {
                            const int gn = 2 * bj + n;
                            const u32x2 w2 = pw[0][m][gn];
                            const f32x4 pv = {bf_lo(w2.x), bf_hi(w2.x), bf_lo(w2.y), bf_hi(w2.y)};
                            sum += sigmoid4(acc[ai][bj][m][n] + gb[gn]) * pv;
                        }
                    u32x2 w; w.x = cvt_pk_bf16(sum[0], sum[1]); w.y = cvt_pk_bf16(sum[2], sum[3]);
                    *(u32x2*)(MG + row * DM + mc) = w;
                }
                asm volatile("" ::: "memory");
            }
        }
    }
};

__device__ __forceinline__ void glds_s(const char* gbase, unsigned voff, unsigned lds_dst) {
    unsigned keep;
    asm volatile("s_mov_b32 %0, m0\n\ts_mov_b32 m0, %3\n\ts_nop 2\n\tglobal_load_lds_dwordx4 %1, %2\n\ts_mov_b32 m0, %0" : "=&s"(keep) : "v"(voff), "s"(gbase), "s"(lds_dst) : "memory");
}
template <class Epi, class Sched>
__device__ __forceinline__ void gemm_phase(LAS unsigned char* lds, const Gemm g, const Sched& S, const Epi& E, const int tid) {
    const int wid = __builtin_amdgcn_readfirstlane(tid >> 6), lane = tid & 63, wr = wid >> 2, wc = wid & 3, fr = lane & 15, fq = lane >> 4;
    const int K = g.K, nt = K / BK;
    unsigned voffA, voffB;
    { int R, C; stage_rc(tid * 16, R, C); const int Rb = E.perm() ? ((R & ~31) + perm32(R & 31)) : R; voffA = (unsigned)(R * K + C) * 2u; voffB = (unsigned)(Rb * K + C) * 2u; }
    const size_t rstep = (size_t)64 * K * 2;
    const size_t kstep = (size_t)(BK * 2);
    const size_t hstep = (size_t)HALF * K * 2, tstep = 2 * hstep;
    const unsigned ldsb = (unsigned)(uintptr_t)lds + (unsigned)wid * 1024u;
    const int aoff = lds_byte(wr * 64 + fr, fq * 8), boff = lds_byte(wc * 32 + fr, fq * 8);
#define PG8_SA(b, h) (((b) * 2 + (h)) * HTB)
#define PG8_SB(b, h) ((4 + (b) * 2 + (h)) * HTB)
#define PG8_STAGE(bufoff, gbase, voff) do { glds_s((const char*)(gbase), (voff), ldsb + (bufoff)); glds_s((const char*)(gbase) + rstep, (voff), ldsb + (bufoff) + 8192u); } while (0)
#define PG8_LDA(dst, b, h) do { _Pragma("unroll") for (int m = 0; m < 4; ++m) _Pragma("unroll") for (int k = 0; k < 2; ++k) dst[m][k] = *(const LAS bf16x8*)(lds + PG8_SA(b, h) + aoff + m * 2048 + k * 1024); } while (0)
#define PG8_LDB(dst, b, h) do { _Pragma("unroll") for (int n = 0; n < 2; ++n) _Pragma("unroll") for (int k = 0; k < 2; ++k) dst[n][k] = *(const LAS bf16x8*)(lds + PG8_SB(b, h) + boff + n * 2048 + k * 1024); } while (0)
#define PG8_MMA(ai, bj, At, Bt) do { __builtin_amdgcn_s_setprio(1); _Pragma("unroll") for (int m = 0; m < 4; ++m) _Pragma("unroll") for (int n = 0; n < 2; ++n) _Pragma("unroll") for (int k = 0; k < 2; ++k) \
        acc[ai][bj][m][n] = __builtin_amdgcn_mfma_f32_16x16x32_bf16(Bt[n][k], At[m][k], acc[ai][bj][m][n], 0, 0, 0); __builtin_amdgcn_s_setprio(0); } while (0)
#define PG8_WAIT_V(n) asm volatile("s_waitcnt vmcnt(" #n ")" ::: "memory")
#define PG8_WAIT_L(n) asm volatile("s_waitcnt lgkmcnt(" #n ")" ::: "memory")
#define PG8_BAR __builtin_amdgcn_s_barrier()
#define PG8_SCHED __builtin_amdgcn_sched_barrier(0)
    Unit cur, nxt; int ui = 0;
    if (!S.next(0, cur)) return;
    Acc acc;
#pragma unroll
    for (int a = 0; a < 2; ++a)
#pragma unroll
        for (int b = 0; b < 2; ++b)
#pragma unroll
            for (int m = 0; m < 4; ++m)
#pragma unroll
                for (int n = 0; n < 2; ++n) acc[a][b][m][n] = (f32x4){0.f, 0.f, 0.f, 0.f};
    bf16x8 At[4][2], B0[2][2], B1[2][2];
    const char* cA = (const char*)g.A + (size_t)cur.pm * tstep + cur.ao; const char* cB = (const char*)g.Bt + (size_t)cur.pn * tstep;
    PG8_STAGE(PG8_SB(0, 0), cB, voffB); PG8_STAGE(PG8_SB(0, 1), cB + hstep, voffB); PG8_STAGE(PG8_SA(0, 0), cA, voffA); PG8_STAGE(PG8_SA(0, 1), cA + hstep, voffA);
    if (wr == 1) PG8_BAR;
    PG8_WAIT_V(2); PG8_BAR;
    PG8_STAGE(PG8_SB(1, 0), cB + kstep, voffB); PG8_STAGE(PG8_SA(1, 0), cA + kstep, voffA); PG8_STAGE(PG8_SB(1, 1), cB + hstep + kstep, voffB);
    PG8_WAIT_V(6); PG8_BAR;
    for (;;) {
        const bool has_next = S.next(ui + 1, nxt);
        const char* nA = has_next ? (const char*)g.A + (size_t)nxt.pm * tstep + nxt.ao : cA; const char* nB = has_next ? (const char*)g.Bt + (size_t)nxt.pn * tstep : cB;
        for (int t = 0; t < nt; t += 2) {
            const bool last = (t == nt - 2);
            const char* a1 = cA + (size_t)(t + 1) * kstep;
            const char* a2 = last ? nA : cA + (size_t)(t + 2) * kstep; const char* b2 = last ? nB : cB + (size_t)(t + 2) * kstep;
            const char* a3 = a2 + kstep; const char* b3 = b2 + kstep;
            const bool relax = (t == 0) && (ui > 0);
            PG8_LDB(B0, 0, 0); PG8_LDB(B1, 0, 1); PG8_SCHED; PG8_LDA(At, 0, 0); if (!relax) PG8_STAGE(PG8_SA(1, 1), a1 + hstep, voffA);
            if (relax) PG8_WAIT_V(16); else PG8_WAIT_V(8);
            PG8_WAIT_L(0); PG8_BAR; PG8_MMA(0, 0, At, B0); PG8_MMA(0, 1, At, B1); PG8_BAR; PG8_SCHED;
            PG8_LDA(At, 0, 1); PG8_STAGE(PG8_SB(0, 0), b2, voffB); PG8_STAGE(PG8_SB(0, 1), b2 + hstep, voffB); PG8_STAGE(PG8_SA(0, 0), a2, voffA);
            if (relax) PG8_WAIT_V(16); else PG8_WAIT_V(8);
            PG8_WAIT_L(0); PG8_BAR; PG8_MMA(1, 0, At, B0); PG8_MMA(1, 1, At, B1); PG8_BAR; PG8_SCHED;
            PG8_LDB(B0, 1, 0); PG8_LDB(B1, 1, 1); PG8_SCHED; PG8_LDA(At, 1, 0); PG8_STAGE(PG8_SA(0, 1), a2 + hstep, voffA);
            if (relax) PG8_WAIT_V(16); else PG8_WAIT_V(8);
            PG8_WAIT_L(0); PG8_BAR; PG8_MMA(0, 0, At, B0); PG8_MMA(0, 1, At, B1); PG8_BAR; PG8_SCHED;
            PG8_LDA(At, 1, 1); PG8_STAGE(PG8_SB(1, 0), b3, voffB); PG8_STAGE(PG8_SB(1, 1), b3 + hstep, voffB); PG8_STAGE(PG8_SA(1, 0), a3, voffA);
            PG8_WAIT_V(8); PG8_WAIT_L(0); PG8_BAR; PG8_MMA(1, 0, At, B0); PG8_MMA(1, 1, At, B1); PG8_BAR; PG8_SCHED;
        }
        if (wr == 0) PG8_BAR;
        if (has_next) PG8_STAGE(PG8_SA(1, 1), nA + kstep + hstep, voffA);
        E(acc, cur, wr, wc, fr, fq);
        if (!has_next) break;
#pragma unroll
        for (int a = 0; a < 2; ++a)
#pragma unroll
            for (int b = 0; b < 2; ++b)
#pragma unroll
                for (int m = 0; m < 4; ++m)
#pragma unroll
                    for (int n = 0; n < 2; ++n) acc[a][b][m][n] = (f32x4){0.f, 0.f, 0.f, 0.f};
        cur = nxt; cA = nA; cB = nB; ++ui;
        if (wr == 1) PG8_BAR;
    }
    PG8_WAIT_V(0);
    PG8_BAR;
#undef PG8_SA
#undef PG8_SB
#undef PG8_STAGE
#undef PG8_LDA
#undef PG8_LDB
#undef PG8_MMA
#undef PG8_WAIT_V
#undef PG8_WAIT_L
#undef PG8_BAR
#undef PG8_SCHED
}
}

constexpr size_t MiB = 1u << 20;
constexpr size_t WS_W = 1 * MiB;
constexpr size_t WL_UP0 = 0, WL_UP1 = 11534336, WL_DN0 = 23068672, WL_DN1 = 28835840, WL_IN = 34603008, WL_GATE = 38797312, WL_BR = 47185920, WL_OUT = 49283072, WL_SIZE = 51380224;
constexpr size_t WS_XB = 100 * MiB;
constexpr size_t WS_H = 164 * MiB;
constexpr size_t WS_YC = 164 * MiB;
constexpr size_t WS_QB = 228 * MiB, WS_KB = 244 * MiB, WS_VT = 260 * MiB, WS_UB = 276 * MiB, WS_V2B = 292 * MiB, WS_PLB = 308 * MiB, WS_CGB = 324 * MiB;
constexpr size_t WS_P = 256 * MiB;
constexpr size_t WS_YLAST = 384 * MiB;
constexpr size_t WS_END = 512 * MiB;
static_assert(WS_W + 2 * WL_SIZE <= WS_XB && WS_H + (size_t)MTOK * FF * 2 <= 340 * MiB && WS_CGB + 16 * MiB <= 340 * MiB, "ws map");

constexpr int RING_BYTES = 131072, LDS_BYTES = 147456, MISC_OFF = RING_BYTES + 320;
constexpr size_t WS_STATS = 128 * 1024;
constexpr size_t WS_LNP = 768 * 1024;
constexpr size_t WS_POOLWT = 400 * 1024;
constexpr size_t WS_SGW = 512 * 1024;
constexpr size_t WS_CTL = 0, CTL_ZERO_BYTES = 65536; constexpr int CW_BAR = 4096;

__device__ __forceinline__ int dst_row(int mode, int n, int aux) {
    if (mode == 0) return n + aux;
    if (mode == 1) { const int isup = n >= FF ? 1 : 0, j = isup ? n - FF : n; return 256 * (j >> 7) + 128 * isup + (j & 127); }
    if (mode == 2) { if (n < 1536) return n; const int c = (n - 1536) & 255, isg = (n - 1536) >> 8; return 256 * (6 + (c >> 7)) + 128 * isg + (c & 127); }
    { const int pn = n >> 6, wc = (n >> 4) & 3, rest = n & 15; return 256 * pn + 128 * (aux >> 1) + 32 * wc + 16 * (aux & 1) + rest; }
}
__device__ __forceinline__ void transpose_item(const float* W, int K, int N, bf16_t* WT, int mode, int aux, LAS float* scr, int item, int lane) {
    const int nblk = N / 32, kb = item / nblk, nb = item % nblk, k0 = 64 * kb, n0 = 32 * nb;
#pragma unroll 8
    for (int i = 0; i < 32; ++i) { const int kk = 2 * i + (lane >> 5); scr[kk * 33 + (lane & 31)] = W[(size_t)(k0 + kk) * N + n0 + (lane & 31)]; }
    asm volatile("s_waitcnt lgkmcnt(0)" ::: "memory");
    const int c = lane & 7;
#pragma unroll
    for (int j = 0; j < 4; ++j) { const int n = (lane >> 3) + 8 * j; const LAS float* s = scr + (8 * c) * 33 + n;
        u32x4 o; o.x = cvt_pk_bf16(s[0 * 33], s[1 * 33]); o.y = cvt_pk_bf16(s[2 * 33], s[3 * 33]); o.z = cvt_pk_bf16(s[4 * 33], s[5 * 33]); o.w = cvt_pk_bf16(s[6 * 33], s[7 * 33]);
        *(u32x4*)(WT + (size_t)dst_row(mode, n0 + n, aux) * K + k0 + 8 * c) = o; }
    asm volatile("s_waitcnt lgkmcnt(0)" ::: "memory");
}

__device__ __forceinline__ void convert_layer_weights(int l, const float* w_up, const float* w_dn, const float* w_in, const float* w_gate, const float* w_br, const float* w_out,
                                                      unsigned char* ws, LAS float* scr, int gw, int NGW, int lane) {
    constexpr int NL = 12544;
    bf16_t* wl = (bf16_t*)(ws + WS_W + (size_t)l * WL_SIZE);
    for (int it = gw; it < NL; it += NGW) {
        int r = it;
        if (r < 5632) { const int f = r / 2816; transpose_item(w_up + (size_t)(l * 2 + f) * DM * 2 * FF, DM, 2 * FF, wl + (f ? WL_UP1 : WL_UP0) / 2, 1, 0, scr, r % 2816, lane); continue; } r -= 5632;
        if (r < 2816) { const int f = r / 1408; transpose_item(w_dn + (size_t)(l * 2 + f) * FF * DM, FF, DM, wl + (f ? WL_DN1 : WL_DN0) / 2, 0, 0, scr, r % 1408, lane); continue; } r -= 2816;
        if (r < 1024) { transpose_item(w_in + (size_t)l * DM * INC, DM, INC, wl + WL_IN / 2, 2, 0, scr, r, lane); continue; } r -= 1024;
        if (r < 2048) { const int n = r / 512; transpose_item(w_gate + (size_t)(l * 4 + n) * DM * DM, DM, DM, wl + WL_GATE / 2, 3, n, scr, r % 512, lane); continue; } r -= 2048;
        if (r < 512) { const int n = r / 128; transpose_item(w_br + (size_t)(l * 4 + n) * BW * DM, BW, DM, wl + WL_BR / 2, 0, n * DM, scr, r % 128, lane); continue; } r -= 512;
        transpose_item(w_out + (size_t)l * DM * DM, DM, DM, wl + WL_OUT / 2, 0, 0, scr, r, lane);
    }
}

__device__ __forceinline__ void ln_pass(const float* YF, float* OUT, const bf16_t* YB, bf16_t* XB, float* stats, const float* g, const float* b, bool final, int gw, int NGW, int lane) {
    if (final) {
        f32x4 gg[4], bb[4];
#pragma unroll
        for (int j = 0; j < 4; ++j) { gg[j] = ((const f32x4*)g)[lane + 64 * j]; bb[j] = ((const f32x4*)b)[lane + 64 * j]; }
        for (int m = gw; m < MTOK; m += NGW) {
            const f32x4* xr = (const f32x4*)(YF + (size_t)m * DM) + lane; f32x4* orow = (f32x4*)(OUT + (size_t)m * DM) + lane;
            f32x4 v[4]; float s = 0.f;
#pragma unroll
            for (int j = 0; j < 4; ++j) { v[j] = xr[64 * j]; s += (v[j].x + v[j].y) + (v[j].z + v[j].w); }
            const float mean = wave_sum(s) * (1.f / DM); float s2 = 0.f;
#pragma unroll
            for (int j = 0; j < 4; ++j) { v[j] = v[j] - mean; s2 += (v[j].x * v[j].x + v[j].y * v[j].y) + (v[j].z * v[j].z + v[j].w * v[j].w); }
            const float rstd = 1.f / sqrtf(wave_sum(s2) * (1.f / DM) + ln_eps_s());
#pragma unroll
            for (int j = 0; j < 4; ++j) orow[64 * j] = v[j] * rstd * gg[j] + bb[j];
        }
    } else {
        f32x4 gg[4], bb[4];
#pragma unroll
        for (int j = 0; j < 2; ++j) { gg[2 * j] = ((const f32x4*)g)[128 * j + 2 * lane]; gg[2 * j + 1] = ((const f32x4*)g)[128 * j + 2 * lane + 1]; bb[2 * j] = ((const f32x4*)b)[128 * j + 2 * lane]; bb[2 * j + 1] = ((const f32x4*)b)[128 * j + 2 * lane + 1]; }
        for (int m = gw; m < MTOK; m += NGW) {
            const u32x4* xr = (const u32x4*)(YB + (size_t)m * DM) + lane; u32x4* orow = (u32x4*)(XB + (size_t)m * DM) + lane;
            const u32x4 r0 = xr[0], r1 = xr[64];
            f32x4 v[4] = {{bf_lo(r0.x), bf_hi(r0.x), bf_lo(r0.y), bf_hi(r0.y)}, {bf_lo(r0.z), bf_hi(r0.z), bf_lo(r0.w), bf_hi(r0.w)},
                          {bf_lo(r1.x), bf_hi(r1.x), bf_lo(r1.y), bf_hi(r1.y)}, {bf_lo(r1.z), bf_hi(r1.z), bf_lo(r1.w), bf_hi(r1.w)}};
            float s = 0.f;
#pragma unroll
            for (int j = 0; j < 4; ++j) s += (v[j].x + v[j].y) + (v[j].z + v[j].w);
            const float mean = wave_sum(s) * (1.f / DM); float s2 = 0.f;
#pragma unroll
            for (int j = 0; j < 4; ++j) { v[j] = v[j] - mean; s2 += (v[j].x * v[j].x + v[j].y * v[j].y) + (v[j].z * v[j].z + v[j].w * v[j].w); }
            const float rstd = 1.f / sqrtf(wave_sum(s2) * (1.f / DM) + ln_eps_s());
            f32x4 o[4];
#pragma unroll
            for (int j = 0; j < 4; ++j) o[j] = v[j] * rstd * gg[j] + bb[j];
            u32x4 w0, w1;
            w0.x = cvt_pk_bf16(o[0].x, o[0].y); w0.y = cvt_pk_bf16(o[0].z, o[0].w); w0.z = cvt_pk_bf16(o[1].x, o[1].y); w0.w = cvt_pk_bf16(o[1].z, o[1].w);
            w1.x = cvt_pk_bf16(o[2].x, o[2].y); w1.y = cvt_pk_bf16(o[2].z, o[2].w); w1.z = cvt_pk_bf16(o[3].x, o[3].y); w1.w = cvt_pk_bf16(o[3].z, o[3].w);
            orow[0] = w0; orow[64] = w1;
            if (lane == 0) *(f32x2*)(stats + (size_t)m * 2) = (f32x2){mean, rstd};
        }
    }
}


__device__ __forceinline__ void ld_u16_s12(unsigned (&r)[12], unsigned voff, const void* const (&p)[12]) {
    asm volatile(
        "s_nop 4\n\t"
        "global_load_ushort %0, %12, %13\n\t"
        "global_load_ushort %1, %12, %14\n\t"
        "global_load_ushort %2, %12, %15\n\t"
        "global_load_ushort %3, %12, %16\n\t"
        "global_load_ushort %4, %12, %17\n\t"
        "global_load_ushort %5, %12, %18\n\t"
        "global_load_ushort %6, %12, %19\n\t"
        "global_load_ushort %7, %12, %20\n\t"
        "global_load_ushort %8, %12, %21\n\t"
        "global_load_ushort %9, %12, %22\n\t"
        "global_load_ushort %10, %12, %23\n\t"
        "global_load_ushort %11, %12, %24\n\t"
        "s_waitcnt vmcnt(0)"
        : "=&v"(r[0]), "=&v"(r[1]), "=&v"(r[2]), "=&v"(r[3]), "=&v"(r[4]), "=&v"(r[5]), "=&v"(r[6]), "=&v"(r[7]), "=&v"(r[8]), "=&v"(r[9]), "=&v"(r[10]), "=&v"(r[11])
        : "v"(voff), "s"(p[0]), "s"(p[1]), "s"(p[2]), "s"(p[3]), "s"(p[4]), "s"(p[5]), "s"(p[6]), "s"(p[7]), "s"(p[8]), "s"(p[9]), "s"(p[10]), "s"(p[11])
        : "memory");
}
__device__ __forceinline__ void ld_u16_s8(unsigned (&r)[8], unsigned voff, const void* const (&p)[8]) {
    asm volatile(
        "s_nop 4\n\t"
        "global_load_ushort %0, %8, %9\n\t"
        "global_load_ushort %1, %8, %10\n\t"
        "global_load_ushort %2, %8, %11\n\t"
        "global_load_ushort %3, %8, %12\n\t"
        "global_load_ushort %4, %8, %13\n\t"
        "global_load_ushort %5, %8, %14\n\t"
        "global_load_ushort %6, %8, %15\n\t"
        "global_load_ushort %7, %8, %16\n\t"
        "s_waitcnt vmcnt(0)"
        : "=&v"(r[0]), "=&v"(r[1]), "=&v"(r[2]), "=&v"(r[3]), "=&v"(r[4]), "=&v"(r[5]), "=&v"(r[6]), "=&v"(r[7])
        : "v"(voff), "s"(p[0]), "s"(p[1]), "s"(p[2]), "s"(p[3]), "s"(p[4]), "s"(p[5]), "s"(p[6]), "s"(p[7])
        : "memory");
}
__device__ __forceinline__ void ld_u16_s4(unsigned (&r)[4], unsigned voff, const void* const (&p)[4]) {
    asm volatile(
        "s_nop 4\n\t"
        "global_load_ushort %0, %4, %5\n\t"
        "global_load_ushort %1, %4, %6\n\t"
        "global_load_ushort %2, %4, %7\n\t"
        "global_load_ushort %3, %4, %8\n\t"
        "s_waitcnt vmcnt(0)"
        : "=&v"(r[0]), "=&v"(r[1]), "=&v"(r[2]), "=&v"(r[3])
        : "v"(voff), "s"(p[0]), "s"(p[1]), "s"(p[2]), "s"(p[3])
        : "memory");
}
__device__ __forceinline__ void ld_b128_s8(u32x4 (&r)[8], unsigned voff, const void* const (&p)[8]) {
    asm volatile(
        "s_nop 4\n\t"
        "global_load_dwordx4 %0, %8, %9\n\t"
        "global_load_dwordx4 %1, %8, %10\n\t"
        "global_load_dwordx4 %2, %8, %11\n\t"
        "global_load_dwordx4 %3, %8, %12\n\t"
        "global_load_dwordx4 %4, %8, %13\n\t"
        "global_load_dwordx4 %5, %8, %14\n\t"
        "global_load_dwordx4 %6, %8, %15\n\t"
        "global_load_dwordx4 %7, %8, %16\n\t"
        "s_waitcnt vmcnt(0)"
        : "=&v"(r[0]), "=&v"(r[1]), "=&v"(r[2]), "=&v"(r[3]), "=&v"(r[4]), "=&v"(r[5]), "=&v"(r[6]), "=&v"(r[7])
        : "v"(voff), "s"(p[0]), "s"(p[1]), "s"(p[2]), "s"(p[3]), "s"(p[4]), "s"(p[5]), "s"(p[6]), "s"(p[7])
        : "memory");
}
__device__ __forceinline__ void ld_b128_s4(u32x4 (&r)[4], unsigned voff, const void* const (&p)[4]) {
    asm volatile(
        "s_nop 4\n\t"
        "global_load_dwordx4 %0, %4, %5\n\t"
        "global_load_dwordx4 %1, %4, %6\n\t"
        "global_load_dwordx4 %2, %4, %7\n\t"
        "global_load_dwordx4 %3, %4, %8\n\t"
        "s_waitcnt vmcnt(0)"
        : "=&v"(r[0]), "=&v"(r[1]), "=&v"(r[2]), "=&v"(r[3])
        : "v"(voff), "s"(p[0]), "s"(p[1]), "s"(p[2]), "s"(p[3])
        : "memory");
}
__device__ __forceinline__ int crow(int r, int hi) { return (r & 3) + 8 * (r >> 2) + 4 * hi; }
__device__ __forceinline__ void attn_item(int item, const bf16_t* QB, const bf16_t* KB, const bf16_t* VT, bf16_t* YC, int lane) {
    const int qb = item & 127, bh = item >> 7, b = bh >> 2, h = bh & 3;
    const int q = lane & 31, hi = lane >> 5;
    const size_t rowbase = (size_t)b * SEQ; const int t0 = qb * 32;
    bf16x8 Qf[4];
#pragma unroll
    for (int d0 = 0; d0 < 4; ++d0) Qf[d0] = *(const bf16x8*)(QB + (rowbase + t0 + q) * BW + h * 64 + d0 * 16 + hi * 8);
    f32x16 o0 = {}, o1 = {};
    float carry = 1.f;
    const u32x4* kfb = (const u32x4*)KB + (size_t)bh * (SEQ / 32) * 256 + lane;
    const u32x4* vfb = (const u32x4*)VT + (size_t)bh * (SEQ / 32) * 256 + lane;
    bf16x8 Kn[4], Km[4]; u32x2 vn[2][2][2], vm[2][2][2];
#define ATT_LOAD(KD, VD, KT) do { const u32x4* kt_ = kfb + (size_t)(KT) * 256; \
        _Pragma("unroll") for (int d0 = 0; d0 < 4; ++d0) KD[d0] = __builtin_bit_cast(bf16x8, kt_[d0 * 64]); \
        const u32x4* vt_ = vfb + (size_t)(KT) * 256; \
        _Pragma("unroll") for (int dh = 0; dh < 2; ++dh) _Pragma("unroll") for (int a = 0; a < 2; ++a) { const u32x4 t_ = vt_[(a * 2 + dh) * 64]; VD[dh][a][0] = (u32x2){t_.x, t_.y}; VD[dh][a][1] = (u32x2){t_.z, t_.w}; } } while (0)
    ATT_LOAD(Kn, vn, qb);
    ATT_LOAD(Km, vm, qb > 0 ? qb - 1 : 0);
    for (int kt = qb; kt >= 0; --kt) {
        bf16x8 Kf[4]; u32x2 vraw[2][2][2];
#pragma unroll
        for (int d0 = 0; d0 < 4; ++d0) { Kf[d0] = Kn[d0]; Kn[d0] = Km[d0]; }
#pragma unroll
        for (int dh = 0; dh < 2; ++dh)
#pragma unroll
            for (int a = 0; a < 2; ++a) { vraw[dh][a][0] = vn[dh][a][0]; vraw[dh][a][1] = vn[dh][a][1]; vn[dh][a][0] = vm[dh][a][0]; vn[dh][a][1] = vm[dh][a][1]; }
        if (kt > 1) ATT_LOAD(Km, vm, kt - 2);
        f32x16 p = {};
#pragma unroll
        for (int d0 = 0; d0 < 4; ++d0) p = __builtin_amdgcn_mfma_f32_32x32x16_bf16(Kf[d0], Qf[d0], p, 0, 0, 0);
        const bool diag = (kt == qb);
        float bt[16], kp[16];
#pragma unroll
        for (int r = 0; r < 16; ++r) {
            const float e = __builtin_amdgcn_exp2f(fminf(p[r], 60.f));
            const float rc = __builtin_amdgcn_rcpf(1.f + e);
            const bool ok = !diag || (crow(r, hi) < q);
            kp[r] = ok ? rc : 1.f; bt[r] = ok ? e * rc : 0.f;
        }
        float own[4], oth[4], sg[4];
#pragma unroll
        for (int i = 0; i < 4; ++i) { own[i] = (kp[4 * i] * kp[4 * i + 1]) * (kp[4 * i + 2] * kp[4 * i + 3]); oth[i] = partner32(own[i]); }
        float tot = 1.f;
#pragma unroll
        for (int i = 3; i >= 0; --i) { sg[i] = tot * (hi == 0 ? oth[i] : 1.f); tot *= own[i] * oth[i]; }
        float w[16];
#pragma unroll
        for (int i = 0; i < 4; ++i) {
            const float a3 = sg[i] * carry, a2 = a3 * kp[4 * i + 3], a1 = a2 * kp[4 * i + 2], a0 = a1 * kp[4 * i + 1];
            w[4 * i + 3] = bt[4 * i + 3] * a3; w[4 * i + 2] = bt[4 * i + 2] * a2; w[4 * i + 1] = bt[4 * i + 1] * a1; w[4 * i + 0] = bt[4 * i + 0] * a0;
        }
        carry *= tot;
#pragma unroll
        for (int a = 0; a < 2; ++a) {
            u32x4 pw; pw.x = cvt_pk_bf16(w[8 * a + 0], w[8 * a + 1]); pw.y = cvt_pk_bf16(w[8 * a + 2], w[8 * a + 3]); pw.z = cvt_pk_bf16(w[8 * a + 4], w[8 * a + 5]); pw.w = cvt_pk_bf16(w[8 * a + 6], w[8 * a + 7]);
            const bf16x8 Pa = __builtin_bit_cast(bf16x8, pw);
            u32x4 v0; v0.x = vraw[0][a][0].x; v0.y = vraw[0][a][0].y; v0.z = vraw[0][a][1].x; v0.w = vraw[0][a][1].y;
            u32x4 v1; v1.x = vraw[1][a][0].x; v1.y = vraw[1][a][0].y; v1.z = vraw[1][a][1].x; v1.w = vraw[1][a][1].y;
            o0 = __builtin_amdgcn_mfma_f32_32x32x16_bf16(Pa, __builtin_bit_cast(bf16x8, v0), o0, 0, 0, 0);
            o1 = __builtin_amdgcn_mfma_f32_32x32x16_bf16(Pa, __builtin_bit_cast(bf16x8, v1), o1, 0, 0, 0);
        }
        if (__all(carry < 1e-37f)) break;
    }
#undef ATT_LOAD
#pragma unroll
    for (int r = 0; r < 16; ++r) {
        bf16_t* orow = YC + (rowbase + t0 + crow(r, hi)) * BW + h * 64 + q;
        orow[0] = f2bf(o0[r]); orow[32] = f2bf(o1[r]);
    }
}

__device__ __forceinline__ void sg_item(int l, int chunk, LAS unsigned char* lds, const bf16_t* UB, const bf16_t* V2T, bf16_t* YC1, const bf16_t* Wb,
                                        const float* sg_ln_g, const float* sg_ln_b, const float* sg_b, int lane, int wave) {
    constexpr int VS = 136;
    LAS bf16_t* vT = (LAS bf16_t*)lds;
    LAS float* part = (LAS float*)(lds + 256 * VS * 2);
    const size_t r0 = (size_t)chunk * 128; const int b = (int)(r0 >> 12), pos0 = (int)(r0 & (SEQ - 1));
    {
        const int th = wave & 1, cq = wave >> 1, s = 64 * th + lane;
        const bf16_t* src = V2T + ((size_t)b * BW + 64 * cq) * SEQ + pos0;
        float v[64]; float sum = 0.f, sq = 0.f;
#pragma unroll
        for (int cb = 0; cb < 64; cb += 8) {
            unsigned raw[8]; const void* pp[8];
#pragma unroll
            for (int j = 0; j < 8; ++j) pp[j] = src + (size_t)(cb + j) * SEQ;
            ld_u16_s8(raw, (unsigned)s * 2u, pp);
#pragma unroll
            for (int j = 0; j < 8; ++j) v[cb + j] = __uint_as_float(raw[j] << 16);
        }
#pragma unroll
        for (int c = 0; c < 64; ++c) { sum += v[c]; sq += v[c] * v[c]; }
        part[(cq * 128 + s) * 2] = sum; part[(cq * 128 + s) * 2 + 1] = sq;
        const float gl = sg_ln_g[l * BW + 64 * cq + lane], bl = sg_ln_b[l * BW + 64 * cq + lane];
        __syncthreads();
        float ts = 0.f, tq = 0.f;
#pragma unroll
        for (int k = 0; k < 4; ++k) { ts += part[(k * 128 + s) * 2]; tq += part[(k * 128 + s) * 2 + 1]; }
        const float mean = ts * (1.f / BW), var = fmaxf(tq * (1.f / BW) - mean * mean, 0.f), rstd = 1.f / sqrtf(var + ln_eps_s());
#pragma unroll
        for (int c = 0; c < 64; ++c) {
            const float gc = __uint_as_float(__builtin_amdgcn_readlane(__float_as_uint(gl), c)), bc = __uint_as_float(__builtin_amdgcn_readlane(__float_as_uint(bl), c));
            vT[(64 * cq + c) * VS + s] = f2bf((v[c] - mean) * rstd * gc + bc);
        }
    }
    __syncthreads();
    {
        const int g = wave & 3, dt = wave >> 2, q = lane & 31, hi = lane >> 5, c = 64 * g + 32 * dt + q;
        const bf16_t* Wg = Wb + (size_t)g * 128 * 128;
        const unsigned avoff = (unsigned)(q * 128 + 8 * hi) * 2u;
        f32x16 acc[4] = {};
        bf16x8 Bf[8];
#pragma unroll
        for (int ks = 0; ks < 8; ++ks) Bf[ks] = *(const LAS bf16x8*)(vT + c * VS + 16 * ks + 8 * hi);
#pragma unroll
        for (int i = 0; i < 4; ++i) {
#pragma unroll
            for (int kb = 0; kb < 2 * i + 2; kb += 4) {
                u32x4 af[4]; const void* pp[4];
#pragma unroll
                for (int j = 0; j < 4; ++j) pp[j] = Wg + (size_t)(32 * i) * 128 + 16 * ((kb + j) < 2 * i + 2 ? (kb + j) : 0);
                ld_b128_s4(af, avoff, pp);
#pragma unroll
                for (int j = 0; j < 4; ++j) if (kb + j < 2 * i + 2) acc[i] = __builtin_amdgcn_mfma_f32_32x32x16_bf16(__builtin_bit_cast(bf16x8, af[j]), Bf[kb + j], acc[i], 0, 0, 0);
            }
        }
        const float sb_lo = sg_b[(l * 4 + g) * 128 + lane], sb_hi = sg_b[(l * 4 + g) * 128 + 64 + lane];
        const unsigned uvoff = (unsigned)(4 * hi * BW + c) * 2u;
#pragma unroll
        for (int i = 0; i < 4; ++i) {
            unsigned uu[16];
#pragma unroll
            for (int rb = 0; rb < 16; rb += 8) {
                unsigned raw[8]; const void* pp[8];
#pragma unroll
                for (int j = 0; j < 8; ++j) pp[j] = UB + (r0 + 32 * i + crow(rb + j, 0)) * BW;
                ld_u16_s8(raw, uvoff, pp);
#pragma unroll
                for (int j = 0; j < 8; ++j) uu[rb + j] = raw[j];
            }
#pragma unroll
            for (int r = 0; r < 16; ++r) {
                const int t = 32 * i + crow(r, hi);
                const float sbv = __int_as_float(__builtin_amdgcn_ds_bpermute((t & 63) << 2, __float_as_int(i < 2 ? sb_lo : sb_hi)));
                YC1[(r0 + t) * BW + c] = f2bf(__uint_as_float(uu[r] << 16) * (acc[i][r] + sbv));
            }
        }
    }
    __syncthreads();
}

__device__ __forceinline__ void pool_item(int l, int it, LAS unsigned char* lds, const bf16_t* PLB, bf16_t* YC, const float* pool_w, const float* pool_scale, int tid, int lane, int wave) {
    constexpr int PS = 264, WS_ = 72;
    LAS bf16_t* pl = (LAS bf16_t*)lds;
    const LAS bf16_t* wT = (const LAS bf16_t*)(lds + 65536);
    const size_t r0 = (size_t)it * 64; const int pos0 = (int)(r0 & (SEQ - 1));
    {
        const int c = tid & 255, th = wave >> 2, g = (wave & 3), ts = th * 32;
        float x[47];
#pragma unroll
        for (int ib = 0; ib < 48; ib += 12) {
            unsigned raw[12]; const void* pp[12];
#pragma unroll
            for (int j = 0; j < 12; ++j) { const int off = ts - 15 + (ib + j < 47 ? ib + j : 46); pp[j] = PLB + (r0 + (pos0 + off >= 0 ? off : -pos0)) * BW; }
            ld_u16_s12(raw, (unsigned)c * 2u, pp);
#pragma unroll
            for (int j = 0; j < 12; ++j) if (ib + j < 47) x[ib + j] = (pos0 + ts - 15 + ib + j >= 0) ? __uint_as_float(raw[j] << 16) : 0.f;
        }
#define POOL_WIN(WIN) do { _Pragma("unroll") for (int t = 0; t < 32; ++t) { float s = 0.f; _Pragma("unroll") for (int j = 0; j < WIN; ++j) s += x[15 + t - j]; \
            const int pos = pos0 + ts + t; const float cnt = (float)(pos + 1 < WIN ? pos + 1 : WIN); pl[(ts + t) * PS + c] = f2bf(s / cnt - x[15 + t]); } } while (0)
        if (g == 0) POOL_WIN(2); else if (g == 1) POOL_WIN(4); else if (g == 2) POOL_WIN(8); else POOL_WIN(16);
#undef POOL_WIN
    }
    __syncthreads();
    {
        const int g = wave & 3, tt = wave >> 2, q = lane & 31, hi = lane >> 5;
        f32x16 acc0 = {}, acc1 = {};
#pragma unroll
        for (int ks = 0; ks < 4; ++ks) {
            const bf16x8 Af = *(const LAS bf16x8*)(pl + (tt * 32 + q) * PS + g * 64 + 16 * ks + 8 * hi);
            const bf16x8 B0 = *(const LAS bf16x8*)(wT + (g * 64 + q) * WS_ + 16 * ks + 8 * hi), B1 = *(const LAS bf16x8*)(wT + (g * 64 + 32 + q) * WS_ + 16 * ks + 8 * hi);
            acc0 = __builtin_amdgcn_mfma_f32_32x32x16_bf16(Af, B0, acc0, 0, 0, 0);
            acc1 = __builtin_amdgcn_mfma_f32_32x32x16_bf16(Af, B1, acc1, 0, 0, 0);
        }
        const float sc0 = pool_scale[l * BW + g * 64 + q], sc1 = pool_scale[l * BW + g * 64 + 32 + q];
        bf16_t* orow = YC + (size_t)2 * MTOK * BW + (r0 + tt * 32 + 4 * hi) * BW + g * 64 + q;
#pragma unroll
        for (int r = 0; r < 16; ++r) {
            orow[0] = f2bf(acc0[r] * sc0); orow[32] = f2bf(acc1[r] * sc1);
            orow += ((r & 3) == 3 ? 5 : 1) * BW;
        }
    }
    __syncthreads();
}

__device__ __forceinline__ void conv_item(int l, int it, LAS unsigned char* lds, const bf16_t* CGB, bf16_t* YC, const float* conv_w, const float* conv_b,
                                          const float* conv_ln_g, const float* conv_ln_b, int tid, int lane, int wave) {
    LAS float* cv = (LAS float*)lds;
    const size_t r0 = (size_t)it * 64; const int pos0 = (int)(r0 & (SEQ - 1));
    {
        const int c = tid & 255, th = wave >> 2, ts = th * 32;
        float wd[31];
#pragma unroll
        for (int j = 0; j < 31; ++j) wd[j] = conv_w[(size_t)(l * 31 + j) * BW + c];
        const float bias = conv_b[l * BW + c];
#pragma unroll 1
        for (int pass = 0; pass < 2; ++pass) {
            const int tp = ts + pass * 16;
            float x[46];
#pragma unroll
            for (int ib = 0; ib < 48; ib += 12) {
                unsigned raw[12]; const void* pp[12];
#pragma unroll
                for (int j = 0; j < 12; ++j) { const int off = tp - 30 + (ib + j < 46 ? ib + j : 45); pp[j] = CGB + (r0 + (pos0 + off >= 0 ? off : -pos0)) * BW; }
                ld_u16_s12(raw, (unsigned)c * 2u, pp);
#pragma unroll
                for (int j = 0; j < 12; ++j) if (ib + j < 46) x[ib + j] = (pos0 + tp - 30 + ib + j >= 0) ? __uint_as_float(raw[j] << 16) : 0.f;
            }
#pragma unroll
            for (int t = 0; t < 16; ++t) {
                float acc = bias;
#pragma unroll
                for (int j = 0; j < 31; ++j) acc += wd[j] * x[t + j];
                cv[(tp + t) * BW + c] = acc;
            }
        }
    }
    __syncthreads();
    {
        const f32x4 gg = *(const f32x4*)(conv_ln_g + l * BW + lane * 4), bb = *(const f32x4*)(conv_ln_b + l * BW + lane * 4);
        for (int i = 0; i < 8; ++i) {
            const int row = wave * 8 + i;
            f32x4 v = *(const LAS f32x4*)(cv + row * BW + lane * 4);
            const float mean = wave_sum((v.x + v.y) + (v.z + v.w)) * (1.f / BW);
            v = v - mean;
            const float rstd = 1.f / sqrtf(wave_sum((v.x * v.x + v.y * v.y) + (v.z * v.z + v.w * v.w)) * (1.f / BW) + ln_eps_s());
            const f32x4 y = v * rstd * gg + bb;
            u32x2 w; w.x = cvt_pk_bf16(silu_f(y.x), silu_f(y.y)); w.y = cvt_pk_bf16(silu_f(y.z), silu_f(y.w));
            *(u32x2*)(YC + (size_t)3 * MTOK * BW + (r0 + row) * BW + lane * 4) = w;
        }
    }
    __syncthreads();
}

#define XB_TMO      128
#define XB_XCNT(j)  (256  + 64 * (j))
#define XB_XSUB(j)  (1280 + 64 * (j))
#define XB_XGEN(j)  (2304 + 64 * (j))
#define XB_TOP      3328
#define XB_TOPGEN   3392
#define XCD_BAR_WORDS 3456
#define XB_SPIN_CAP (1u << 18)
__device__ __forceinline__ unsigned xb_ld(unsigned* p)              { return __hip_atomic_load(p, __ATOMIC_RELAXED, __HIP_MEMORY_SCOPE_AGENT); }
__device__ __forceinline__ unsigned xb_add(unsigned* p, unsigned v) { return __hip_atomic_fetch_add(p, v, __ATOMIC_RELAXED, __HIP_MEMORY_SCOPE_AGENT); }
__device__ __forceinline__ unsigned xb_xcc_id() { return (unsigned)__builtin_amdgcn_s_getreg((3 << 11) | 20) & 0xFu; }
#define XB_SPIN(cond, bar) do { unsigned _sp = 0; while (cond) { __builtin_amdgcn_s_sleep(1); \
    if ((++_sp & 255u) == 0u) { if (xb_ld(&(bar)[XB_TMO])) break; if (_sp > XB_SPIN_CAP) { atomicAdd(&(bar)[XB_TMO], 1u); break; } } } } while (0)
__device__ __forceinline__ void xcd_barrier_complete(unsigned* bar, unsigned x, unsigned& nloc, unsigned& nx) {
    const unsigned G = gridDim.x * gridDim.y * gridDim.z;
    unsigned sum, cnt, mine, sp = 0u;
    for (;;) {
        sum = 0u; cnt = 0u; mine = 0u;
#pragma unroll
        for (unsigned j = 0; j < 16; ++j) { const unsigned c = xb_ld(&bar[XB_XCNT(j)]); sum += c; cnt += (c > 0u) ? 1u : 0u; mine = (j == x) ? c : mine; }
        if (sum == G) break;
        __builtin_amdgcn_s_sleep(1);
        if ((++sp & 255u) == 0u) { if (xb_ld(&bar[XB_TMO])) break; if (sp > XB_SPIN_CAP) { atomicAdd(&bar[XB_TMO], 1u); break; } }
    }
    nloc = mine > 0u ? mine : 1u; nx = cnt > 0u ? cnt : 1u;
}
__device__ __forceinline__ void xcd_barrier(unsigned* bar, volatile LAS unsigned* st) {
    asm volatile("s_waitcnt vmcnt(0)" ::: "memory");
    __syncthreads();
    if (threadIdx.x == 0) {
        const unsigned x = xb_xcc_id();
        __builtin_amdgcn_s_waitcnt(0);
        unsigned nloc = st[0], nx = st[1];
        if (nloc == 0u) { xcd_barrier_complete(bar, x, nloc, nx); st[0] = nloc; st[1] = nx; }
        const unsigned old = xb_add(&bar[XB_XSUB(x)], 1u);
        const unsigned gen = old / nloc;
        if (old + 1u == (gen + 1u) * nloc) {
            __builtin_amdgcn_fence(__ATOMIC_RELEASE, "agent");
            asm volatile("s_waitcnt vmcnt(0)" ::: "memory");
            const unsigned og = xb_add(&bar[XB_TOP], 1u);
            const unsigned tg = og / nx;
            if (og + 1u == (tg + 1u) * nx) xb_add(&bar[XB_TOPGEN], 1u);
            else XB_SPIN(xb_ld(&bar[XB_TOPGEN]) == tg, bar);
            __builtin_amdgcn_fence(__ATOMIC_ACQUIRE, "agent");
            xb_add(&bar[XB_XGEN(x)], 1u);
            asm volatile("s_waitcnt vmcnt(0)" ::: "memory");
        } else {
            XB_SPIN(xb_ld(&bar[XB_XGEN(x)]) == gen, bar);
            __builtin_amdgcn_fence(__ATOMIC_ACQUIRE, "agent");
            asm volatile("s_waitcnt vmcnt(0)" ::: "memory");
        }
    }
    __syncthreads();
}

struct Args { const float* in[20]; float* out; unsigned char* ws; int ph_lo, ph_hi; };
constexpr int N_PHASES = 1 + DEPTH * 12;

__global__ void __launch_bounds__(512, 2) __attribute__((amdgpu_waves_per_eu(2, 2))) mk_fwd(Args a_) {
    extern __shared__ __attribute__((aligned(16))) unsigned char lds_raw[];
    cg::grid_group grid = cg::this_grid();
    LAS unsigned char* lds = (LAS unsigned char*)lds_raw;
    const int hi = a_.ph_hi;
    if (threadIdx.x < 64) ((LAS unsigned*)(lds + RING_BYTES))[threadIdx.x * 4 + 0] = 0u, ((LAS unsigned*)(lds + RING_BYTES))[threadIdx.x * 4 + 1] = 0u, ((LAS unsigned*)(lds + RING_BYTES))[threadIdx.x * 4 + 2] = 0u, ((LAS unsigned*)(lds + RING_BYTES))[threadIdx.x * 4 + 3] = 0u;
    __syncthreads();
    if (threadIdx.x == 0) (void)xb_add((unsigned*)(a_.ws + WS_CTL) + CW_BAR + XB_XCNT(xb_xcc_id()), 1u);
    int dup_done = 0; (void)dup_done;
    if (a_.ph_lo == 0) {
        const Args __attribute__((address_space(4)))* ap = (const Args __attribute__((address_space(4)))*)__builtin_amdgcn_kernarg_segment_ptr(); asm volatile("" : "+s"(ap));
        const Args __attribute__((address_space(4)))& a = *ap;
        int bx = blockIdx.x, G = gridDim.x; asm volatile("" : "+s"(bx), "+s"(G));
        int tid = threadIdx.x; asm volatile("" : "+v"(tid));
        const int lane = tid & 63, wave = __builtin_amdgcn_readfirstlane(tid >> 6);
        const int vcu = (G % 8 == 0) ? (bx % 8) * (G / 8) + bx / 8 : bx;
        const int gw = vcu * 8 + wave, NGW = G * 8;
        unsigned char* ws = a.ws;
        {
            LAS float* scr = (LAS float*)(lds + wave * 16384);
            convert_layer_weights(0, a.in[3], a.in[4], a.in[5], a.in[6], a.in[8], a.in[9], ws, scr, gw, NGW, lane);
            for (int i = gw * 64 + lane; i < DEPTH * 4 * 128 * 128; i += NGW * 64) { const int t = (i >> 7) & 127, s = i & 127; ((bf16_t*)(ws + WS_SGW))[i] = f2bf(s <= t ? a.in[12][i] : 0.f); }
            for (int i = gw * 64 + lane; i < DEPTH * 3 * DM; i += NGW * 64) { const int k = i / DM, c = i % DM; ((float*)(ws + WS_LNP))[(k * 2) * DM + c] = a.in[1][i]; ((float*)(ws + WS_LNP))[(k * 2 + 1) * DM + c] = a.in[2][i]; }
            for (int i = gw * 64 + lane; i < DEPTH * 4 * 64 * 64; i += NGW * 64) { const int lg = i >> 12, c = (i >> 6) & 63, d = i & 63; ((bf16_t*)(ws + WS_POOLWT))[(size_t)(lg * 64 + d) * 72 + c] = f2bf(a.in[14][i]); }
            const float* x_in = a.in[0]; bf16_t* XB = (bf16_t*)(ws + WS_XB);
            for (size_t i = (size_t)gw * 64 + lane; i < (size_t)MTOK * DM / 8; i += (size_t)NGW * 64) {
                const f32x4 v0 = ((const f32x4*)x_in)[2 * i], v1 = ((const f32x4*)x_in)[2 * i + 1];
                u32x4 w; w.x = cvt_pk_bf16(v0.x, v0.y); w.y = cvt_pk_bf16(v0.z, v0.w); w.z = cvt_pk_bf16(v1.x, v1.y); w.w = cvt_pk_bf16(v1.z, v1.w);
                ((u32x4*)XB)[i] = w;
            }
        }
        if (hi > 1) xcd_barrier((unsigned*)(ws + WS_CTL) + CW_BAR, (volatile LAS unsigned*)(lds + MISC_OFF));
        if (hi < 0) grid.sync();
    }
    for (int ph = (a_.ph_lo > 0 ? a_.ph_lo : 1); ph < hi; ++ph) {
        const Args __attribute__((address_space(4)))* ap = (const Args __attribute__((address_space(4)))*)__builtin_amdgcn_kernarg_segment_ptr(); asm volatile("" : "+s"(ap));
        const Args __attribute__((address_space(4)))& a = *ap;
        int bx = blockIdx.x, G = gridDim.x; asm volatile("" : "+s"(bx), "+s"(G));
        int tid = threadIdx.x; asm volatile("" : "+v"(tid));
        const int lane = tid & 63, wave = __builtin_amdgcn_readfirstlane(tid >> 6);
        const int vcu = (G % 8 == 0) ? (bx % 8) * (G / 8) + bx / 8 : bx;
        const int gw = vcu * 8 + wave, NGW = G * 8;
        unsigned char* ws = a.ws;
        {
            const int l = (ph - 1) / 12, s = (ph - 1) % 12;
            const unsigned char* wl = ws + WS_W + (size_t)l * WL_SIZE;
            if (s == 2 || s == 8 || s == 11) {
                const int k = s == 2 ? 0 : s == 8 ? 1 : 2;
                ln_pass((const float*)(ws + WS_YLAST), a.out, (const bf16_t*)a.out, (bf16_t*)(ws + WS_XB), (float*)(ws + WS_STATS), a.in[1] + (size_t)(l * 3 + k) * DM, a.in[2] + (size_t)(l * 3 + k) * DM, l == DEPTH - 1 && k == 2, gw, NGW, lane);
            } else if (s == 4) {
                bf16_t* YC = (bf16_t*)(ws + WS_YC);
                const bf16_t *QB = (const bf16_t*)(ws + WS_QB), *KB = (const bf16_t*)(ws + WS_KB), *VT = (const bf16_t*)(ws + WS_VT), *UB = (const bf16_t*)(ws + WS_UB), *V2B = (const bf16_t*)(ws + WS_V2B), *PLB = (const bf16_t*)(ws + WS_PLB), *CGB = (const bf16_t*)(ws + WS_CGB);
#ifndef SKIP_SG
                for (int rr = 0; rr < (PROBE_TM == 1 ? 3 : 1); ++rr)
                for (int it = vcu; it < MTOK / 128; it += G) sg_item(l, it, lds, UB, V2B, YC + (size_t)MTOK * BW, (const bf16_t*)(ws + WS_SGW) + (size_t)l * 4 * 128 * 128, a.in[10], a.in[11], a.in[13], lane, wave);
#endif
                {
                    const u32x4* srcw = (const u32x4*)(ws + WS_POOLWT + (size_t)l * 4 * 64 * 72 * 2);
                    for (int i = tid; i < 4 * 64 * 72 * 2 / 16; i += 512) ((LAS u32x4*)(lds + 65536))[i] = srcw[i];
                    __syncthreads();
                }
#ifndef SKIP_POOL
                for (int rr = 0; rr < (PROBE_TM == 2 ? 3 : 1); ++rr)
                for (int it = vcu; it < MTOK / 64; it += G) pool_item(l, it, lds, PLB, YC, a.in[14], a.in[15], tid, lane, wave);
#endif
#ifndef SKIP_CONV
                for (int rr = 0; rr < (PROBE_TM == 3 ? 3 : 1); ++rr)
                for (int it = vcu; it < MTOK / 64; it += G) conv_item(l, it, lds, CGB, YC, a.in[16], a.in[17], a.in[18], a.in[19], tid, lane, wave);
#endif
#ifndef SKIP_ATTN
                for (int rr = 0; rr < (PROBE_TM == 4 ? 3 : 1); ++rr)
                for (int it = gw; it < BATCH * 4 * (SEQ / 32); it += NGW) attn_item(it, QB, KB, VT, YC, lane);
#endif
                if (l + 1 < DEPTH) {
                    __syncthreads();
                    convert_layer_weights(l + 1, a.in[3], a.in[4], a.in[5], a.in[6], a.in[8], a.in[9], ws, (LAS float*)(lds + wave * 16384), gw, NGW, lane);
                }
            } else {
                pg8::Gemm g; pg8::EpiAny E; pg8::StaticOrder S;
                E.p1 = nullptr; E.p2 = nullptr; E.p3 = ws + WS_STATS; E.p4 = nullptr; E.f0 = 0.f; E.f1 = 0.f;
                if (s == 0 || s == 9) {
                    g = pg8::Gemm{(const bf16_t*)(ws + WS_XB), (const bf16_t*)(wl + (s ? WL_UP1 : WL_UP0)), DM}; S.init(2 * FF, G, bx, 0);
                    E.kind = 0; E.p0 = ws + WS_H;
                } else if (s == 1 || s == 10) {
                    g = pg8::Gemm{(const bf16_t*)(ws + WS_H), (const bf16_t*)(wl + (s == 10 ? WL_DN1 : WL_DN0)), FF}; S.init(DM, G, bx, 0);
                    E.kind = 1; E.p0 = (ph == 2) ? (void*)(ws + WS_XB) : (void*)a.out; E.p1 = a.out; E.f0 = DN_ALPHA; E.f1 = 0.5f;
                    if (ph != 2) E.p2 = ws + WS_LNP + (size_t)((l * 3 + (s == 1 ? 0 : 2)) - 1) * 2 * DM * 4;
                    if (l == DEPTH - 1 && s == 10) E.p4 = ws + WS_YLAST;
                } else if (s == 3) {
                    g = pg8::Gemm{(const bf16_t*)(ws + WS_XB), (const bf16_t*)(wl + WL_IN), DM}; S.init(INC, G, bx, 0);
                    E.kind = 3; E.p0 = ws + WS_QB;
                } else if (s == 5) {
                    g = pg8::Gemm{(const bf16_t*)(ws + WS_YC), (const bf16_t*)(wl + WL_BR), BW}; S.init(4 * DM, G, bx, 1);
                    E.kind = 2; E.p0 = ws + WS_P;
                } else if (s == 6) {
                    g = pg8::Gemm{(const bf16_t*)(ws + WS_XB), (const bf16_t*)(wl + WL_GATE), DM}; S.init(4 * DM, G, bx, 0);
                    E.kind = 4; E.p0 = ws + WS_P; E.p1 = (void*)(a.in[7] + (size_t)l * 4 * DM); E.p2 = ws + WS_YC;
                } else {
                    g = pg8::Gemm{(const bf16_t*)(ws + WS_YC), (const bf16_t*)(wl + WL_OUT), DM}; S.init(DM, G, bx, 0);
                    E.kind = 1; E.p0 = a.out; E.p1 = a.out; E.f0 = DN_ALPHA; E.f1 = 1.0f; E.p2 = ws + WS_LNP + (size_t)(l * 3) * 2 * DM * 4;
                }
#ifndef SKIP_GEMM
                pg8::gemm_phase(lds, g, S, E, tid);
#endif
            }
        }
        if (ph + 1 < hi) {
            xcd_barrier((unsigned*)(ws + WS_CTL) + CW_BAR, (volatile LAS unsigned*)(lds + MISC_OFF));
        }
#ifdef PROBE_DUP
        if (ph > 0 && (ph - 1) % 12 == PROBE_DUP && dup_done < PROBE_N - 1) { ++dup_done; --ph; } else dup_done = 0;
#endif
    }
}

extern "C" void kernel_launch(void* const* d_in, const int* in_sizes, int n_in, void* d_out, int out_size, void* d_ws, size_t ws_size, hipStream_t stream) {
    static int grid = 0;
    if (grid == 0) {
        if (n_in != 20 || in_sizes[0] != MTOK * DM || out_size != MTOK * DM || ws_size < WS_END) { fprintf(stderr, "kernel_launch: unexpected shapes / workspace (n_in %d, ws %zu); nothing launched\n", n_in, ws_size); grid = -1; return; }
        int dev = 0, cus = 0, per_cu = 0;
        if (hipGetDevice(&dev) != hipSuccess || hipDeviceGetAttribute(&cus, hipDeviceAttributeMultiprocessorCount, dev) != hipSuccess) { grid = -1; return; }
        if (hipFuncSetAttribute((const void*)mk_fwd, hipFuncAttributeMaxDynamicSharedMemorySize, LDS_BYTES) != hipSuccess) { fprintf(stderr, "kernel_launch: hipFuncSetAttribute failed\n"); grid = -1; return; }
        if (hipOccupancyMaxActiveBlocksPerMultiprocessor(&per_cu, (const void*)mk_fwd, 512, LDS_BYTES) != hipSuccess || per_cu < 1) { fprintf(stderr, "kernel_launch: occupancy query says %d\n", per_cu); per_cu = 1; }
        (void)hipGetLastError();
        grid = cus;
    }
    if (grid < 0) return;
    if (hipMemsetAsync((char*)d_ws + WS_CTL, 0, CTL_ZERO_BYTES, stream) != hipSuccess) { fprintf(stderr, "kernel_launch: hipMemsetAsync failed\n"); return; }
    Args a{};
    for (int i = 0; i < 20; ++i) a.in[i] = (const float*)d_in[i];
    a.out = (float*)d_out; a.ws = (unsigned char*)d_ws;
#if MK_MULTI_LAUNCH
    for (int p = 0; p < N_PHASES; ++p) {
        a.ph_lo = p; a.ph_hi = p + 1;
        void* args[] = {&a};
        hipError_t e = hipLaunchCooperativeKernel((const void*)mk_fwd, dim3(grid), dim3(512), args, LDS_BYTES, stream);
        if (e != hipSuccess) { fprintf(stderr, "kernel_launch: launch %d failed: %s\n", p, hipGetErrorString(e)); break; }
    }
#else
    a.ph_lo = 0; a.ph_hi = N_PHASES;
    void* args[] = {&a};
    hipError_t e = hipLaunchCooperativeKernel((const void*)mk_fwd, dim3(grid), dim3(512), args, LDS_BYTES, stream);
    if (e != hipSuccess) fprintf(stderr, "kernel_launch: cooperative launch failed: %s (grid %d)\n", hipGetErrorString(e), grid);
#endif
}
```
